# Optimizing an MI355X kernel written in HIP

```python
import math
import jax, jax.numpy as jnp
from jax import lax
import numpy as np

D_MODEL = 1024
BATCH = 8
SEQ = 2048
DEPTH = 1
DEC_BATCH = 32
DEC_SEQ = 8
PAST_LEN = 16384
PAGE_SIZE = 128

HEAD_DIM = 64
N_HEADS_A = 16
W_A = N_HEADS_A * HEAD_DIM
W_R = D_MODEL
N_LRU_BLOCKS = 16
LRU_BLOCK = W_R // N_LRU_BLOCKS
D_MIX = W_A + W_R
D_PROJ = 4 * W_A + 2 * W_R
CONV_W = 4
LRU_C = 8.0
DILATIONS = (1, 4, 16)
N_STEPS = 128
WINDOW_MAX = 2048
BLOCK = 128
N_BUCKETS = 32
MAX_EXACT = 16
MAX_DISTANCE = 2048
EPS = 1e-6
SCALE = HEAD_DIM ** -0.5
NEG_INF = -1e30

kernel_name = "hymba_dilated_swa_rglru_step"


def rmsnorm(x, g):
    xf = x.astype(jnp.float32)
    y = xf * lax.rsqrt(jnp.mean(xf * xf, axis=-1, keepdims=True) + EPS)
    return (y * g.astype(jnp.float32)).astype(x.dtype)


def t5_bucket(dist):
    nf = jnp.maximum(dist, 1).astype(jnp.float32)
    large = MAX_EXACT + (jnp.log(nf / MAX_EXACT) / math.log(MAX_DISTANCE / MAX_EXACT)
                         * (N_BUCKETS - MAX_EXACT)).astype(jnp.int32)
    large = jnp.minimum(large, N_BUCKETS - 1)
    return jnp.where(dist < MAX_EXACT, dist, large)


def dilated_band_prompt(q, k, v, rel_bias, dil):
    B, L, H, Dh = q.shape
    span = dil * BLOCK
    Lp = -(-L // span) * span
    nb = Lp // span

    def to_sub(x):
        x = jnp.pad(x, ((0, 0), (0, Lp - L), (0, 0), (0, 0)))
        x = x.reshape(B, Lp // dil, dil, H, Dh).transpose(0, 2, 1, 3, 4)
        return x.reshape(B, dil, nb, BLOCK, H, Dh)

    qs, ks, vs = to_sub(q), to_sub(k), to_sub(v)

    def with_prev(x):
        prev = jnp.pad(x, ((0, 0), (0, 0), (1, 0), (0, 0), (0, 0), (0, 0)))[:, :, :nb]
        return jnp.concatenate([prev, x], axis=3)

    kb, vb = with_prev(ks), with_prev(vs)
    i = jnp.arange(BLOCK)[:, None]
    j = jnp.arange(2 * BLOCK)[None, :]
    diff = i - j + BLOCK
    band = (diff >= 0) & (diff <= N_STEPS)
    first = (jnp.arange(nb) > 0)[:, None, None] | (j >= BLOCK)[None]
    valid = band[None] & first
    bias = rel_bias[t5_bucket(jnp.maximum(diff, 0) * dil)].transpose(2, 0, 1)
    logits = jnp.einsum('brnqhd,brnkhd->brnhqk', qs, kb).astype(jnp.float32) * SCALE
    logits = logits + bias.astype(jnp.float32)
    logits = jnp.where(valid[None, None, :, None], logits, NEG_INF)
    lse = jax.nn.logsumexp(logits, axis=-1)
    p = jnp.exp(logits - lse[..., None]).astype(v.dtype)
    o = jnp.einsum('brnhqk,brnkhd->brnqhd', p, vb)
    o = o.reshape(B, dil, Lp // dil, H, Dh).transpose(0, 2, 1, 3, 4).reshape(B, Lp, H, Dh)[:, :L]
    lse = lse.transpose(0, 1, 2, 4, 3).reshape(B, dil, Lp // dil, H)
    lse = lse.transpose(0, 2, 1, 3).reshape(B, Lp, H)[:, :L]
    return o, lse


def dilated_gather_sample(q, k_ctx, v_ctx, rel_bias, dil, q_start):
    T = q.shape[1]
    steps = jnp.arange(N_STEPS + 1)
    idx = q_start + jnp.arange(T)[:, None] - dil * steps[None, :]
    valid = idx >= 0
    idx_c = jnp.maximum(idx, 0)
    kg = k_ctx[:, idx_c]
    vg = v_ctx[:, idx_c]
    bias = rel_bias[t5_bucket(dil * steps)].T[:, None, :]
    logits = jnp.einsum('bthd,btshd->bhts', q, kg).astype(jnp.float32) * SCALE
    logits = logits + bias.astype(jnp.float32)
    logits = jnp.where(valid[None, None], logits, NEG_INF)
    lse = jax.nn.logsumexp(logits, axis=-1)
    p = jnp.exp(logits - lse[..., None]).astype(v_ctx.dtype)
    o = jnp.einsum('bhts,btshd->bthd', p, vg)
    return o, lse.transpose(0, 2, 1)


def mixer_layer(x, k_past, v_past, conv_past, h_past, rel_bias, norm_in, w_in, norm_attn,
                norm_lru, conv_w, conv_b, w_gate_x, b_gate_x, w_gate_a, b_gate_a, lru_param, w_out):
    B, T, _ = x.shape
    h = rmsnorm(x, norm_in)
    proj = h @ w_in
    q, k, v, g_a, x_r, g_r = jnp.split(
        proj, [W_A, 2 * W_A, 3 * W_A, 4 * W_A, 4 * W_A + W_R], axis=-1)
    q = q.reshape(B, T, N_HEADS_A, HEAD_DIM)
    k = k.reshape(B, T, N_HEADS_A, HEAD_DIM)
    v = v.reshape(B, T, N_HEADS_A, HEAD_DIM)

    if k_past is None:
        outs = [dilated_band_prompt(q, k, v, rel_bias, d) for d in DILATIONS]
        nkeep = min(WINDOW_MAX, T)
        new_k, new_v = k[:, -nkeep:], v[:, -nkeep:]
    else:
        wb = k_past.shape[1]
        k_ctx = jnp.concatenate([k_past, k], axis=1)
        v_ctx = jnp.concatenate([v_past, v], axis=1)
        outs = [dilated_gather_sample(q, k_ctx, v_ctx, rel_bias, d, wb) for d in DILATIONS]
        new_k, new_v = k_ctx[:, -wb:], v_ctx[:, -wb:]
    lses = jnp.stack([o_l[1] for o_l in outs], axis=0)
    wts = jax.nn.softmax(lses, axis=0)
    o_att = jnp.sum(wts[..., None] * jnp.stack([o_l[0] for o_l in outs], axis=0).astype(jnp.float32), axis=0)
    o_att = o_att.astype(x.dtype).reshape(B, T, W_A)
    y_att = rmsnorm(o_att, norm_attn) * jax.nn.silu(g_a)

    xpad = jnp.concatenate([conv_past.astype(x_r.dtype), x_r], axis=1)
    xc = conv_b + sum(conv_w[tap] * xpad[:, tap:tap + T] for tap in range(CONV_W))
    new_conv = xpad[:, -(CONV_W - 1):]
    xb = xc.reshape(B, T, N_LRU_BLOCKS, LRU_BLOCK)
    gate_x = jax.nn.sigmoid(jnp.einsum('bthi,hij->bthj', xb, w_gate_x).reshape(B, T, W_R) + b_gate_x)
    gate_a = jax.nn.sigmoid(jnp.einsum('bthi,hij->bthj', xb, w_gate_a).reshape(B, T, W_R) + b_gate_a)
    log_a = -LRU_C * gate_a.astype(jnp.float32) * jax.nn.softplus(-lru_param.astype(jnp.float32))
    a = jnp.exp(log_a)
    bx = jnp.sqrt(-jnp.expm1(2.0 * log_a)) * (gate_x * xc).astype(jnp.float32)

    def step(hc, ab):
        a_t, b_t = ab
        hc = a_t * hc + b_t
        return hc, hc

    h_last, hs = lax.scan(step, h_past.astype(jnp.float32),
                          (a.transpose(1, 0, 2), bx.transpose(1, 0, 2)))
    o_lru = hs.transpose(1, 0, 2).astype(x.dtype)
    y_lru = rmsnorm(o_lru, norm_lru) * jax.nn.silu(g_r)

    y = x + jnp.concatenate([y_att, y_lru], axis=-1) @ w_out
    return y, new_k, new_v, new_conv, h_last.astype(h_past.dtype)


def setup_inputs(seed: int = 0) -> dict:
    key = jax.random.key(seed)
    ks = jax.random.split(key, 20)
    wb = min(WINDOW_MAX, PAST_LEN)
    nrm = jax.random.normal
    a0 = jax.random.uniform(ks[16], (DEPTH, W_R), minval=0.9, maxval=0.999)
    s = a0 ** (1.0 / LRU_C)
    return {
        'x_prompt': nrm(ks[0], (BATCH, SEQ, D_MODEL), jnp.float32),
        'x_sample': nrm(ks[1], (DEC_BATCH, DEC_SEQ, D_MODEL), jnp.float32),
        'cache_win_k': nrm(ks[2], (DEPTH, DEC_BATCH, wb, N_HEADS_A, HEAD_DIM), jnp.float32),
        'cache_win_v': nrm(ks[3], (DEPTH, DEC_BATCH, wb, N_HEADS_A, HEAD_DIM), jnp.float32),
        'state_conv': nrm(ks[4], (DEPTH, DEC_BATCH, CONV_W - 1, W_R), jnp.float32),
        'state_lru': 0.5 * nrm(ks[5], (DEPTH, DEC_BATCH, W_R), jnp.float32),
        'rel_bias': 0.1 * nrm(ks[6], (N_BUCKETS, N_HEADS_A), jnp.float32),
        'norm_in': 1.0 + 0.01 * nrm(ks[7], (DEPTH, D_MODEL), jnp.float32),
        'w_in': nrm(ks[8], (DEPTH, D_MODEL, D_PROJ), jnp.float32) * D_MODEL ** -0.5,
        'norm_attn': 1.0 + 0.01 * nrm(ks[9], (DEPTH, W_A), jnp.float32),
        'norm_lru': 1.0 + 0.01 * nrm(ks[10], (DEPTH, W_R), jnp.float32),
        'conv_w': nrm(ks[11], (DEPTH, CONV_W, W_R), jnp.float32) * CONV_W ** -0.5,
        'conv_b': 0.01 * nrm(ks[12], (DEPTH, W_R), jnp.float32),
        'w_gate_x': nrm(ks[13], (DEPTH, N_LRU_BLOCKS, LRU_BLOCK, LRU_BLOCK), jnp.float32) * LRU_BLOCK ** -0.5,
        'b_gate_x': 0.01 * nrm(ks[14], (DEPTH, W_R), jnp.float32),
        'w_gate_a': nrm(ks[15], (DEPTH, N_LRU_BLOCKS, LRU_BLOCK, LRU_BLOCK), jnp.float32) * LRU_BLOCK ** -0.5,
        'b_gate_a': 0.01 * nrm(ks[17], (DEPTH, W_R), jnp.float32),
        'lru_param': jnp.log(s) - jnp.log1p(-s),
        'w_out': nrm(ks[18], (DEPTH, D_MIX, D_MODEL), jnp.float32) * D_MIX ** -0.5,
        'norm_final': 1.0 + 0.01 * nrm(ks[19], (D_MODEL,), jnp.float32),
    }


def reference(x_prompt, x_sample, cache_win_k, cache_win_v, state_conv, state_lru, rel_bias,
              norm_in, w_in, norm_attn, norm_lru, conv_w, conv_b, w_gate_x, b_gate_x,
              w_gate_a, b_gate_a, lru_param, w_out, norm_final):
    xp, xs = x_prompt, x_sample
    kp_l, vp_l, cp_l, hp_l = [], [], [], []
    ks_l, vs_l, cs_l, hs_l = [], [], [], []
    for l in range(DEPTH):
        layer_w = (rel_bias, norm_in[l], w_in[l], norm_attn[l], norm_lru[l], conv_w[l], conv_b[l],
                   w_gate_x[l], b_gate_x[l], w_gate_a[l], b_gate_a[l], lru_param[l], w_out[l])
        conv0 = jnp.zeros((xp.shape[0], CONV_W - 1, W_R), xp.dtype)
        h0 = jnp.zeros((xp.shape[0], W_R), state_lru.dtype)
        xp, kp, vp, cp, hp = mixer_layer(xp, None, None, conv0, h0, *layer_w)
        xs, ks_, vs_, cs_, hs_ = mixer_layer(xs, cache_win_k[l], cache_win_v[l], state_conv[l],
                                             state_lru[l], *layer_w)
        kp_l.append(kp); vp_l.append(vp); cp_l.append(cp); hp_l.append(hp)
        ks_l.append(ks_); vs_l.append(vs_); cs_l.append(cs_); hs_l.append(hs_)
    y_prompt = rmsnorm(xp, norm_final)
    y_sample = rmsnorm(xs, norm_final)
    return (y_prompt, y_sample,
            jnp.stack(kp_l), jnp.stack(vp_l), jnp.stack(cp_l), jnp.stack(hp_l),
            jnp.stack(ks_l), jnp.stack(vs_l), jnp.stack(cs_l), jnp.stack(hs_l))
```

```cpp
#include <hip/hip_runtime.h>
#include <hip/hip_bf16.h>
#include <cstdio>
#include <cstdint>
#include <cmath>

#ifndef MK_N_LAUNCHES
#define MK_N_LAUNCHES 1
#endif

constexpr int DM = 1024, NBATCH = 8, SEQ = 2048, DECB = 32, DECT = 8, WBK = 2048, NHEAD = 16, HDIM = 64;
constexpr int MP = NBATCH * SEQ;
constexpr int MS = DECB * DECT;
constexpr int MT = MP + MS;
constexpr int NPROJ = 6144, DMIX = 2048;
constexpr float EPS = 1e-6f;
constexpr float LOG2E = 1.4426950408889634f;
constexpr float QSCALE = 0.125f * LOG2E;
constexpr size_t O_YP = 0, O_YS = 16777216, O_KP = 17039360, O_VP = 33816576, O_CP = 50593792, O_LP = 50618368,
                 O_KS = 50626560, O_VS = 117735424, O_CS = 184844288, O_LS = 184942592;
constexpr size_t MiB = 1u << 20;
constexpr size_t WS_CTL = 0, CTL_ZERO_BYTES = 1 * MiB;
constexpr size_t WS_WIN = 2 * MiB;
constexpr size_t WS_WOUT = 14 * MiB;
constexpr size_t WS_WG = 18 * MiB;
constexpr size_t WS_TAB = 19 * MiB;
constexpr size_t WS_XN = 32 * MiB;
constexpr size_t WS_P = 66 * MiB;
constexpr size_t WS_Y = 261 * MiB;
constexpr size_t WS_SSQ = 326 * MiB;
constexpr size_t WS_SPO = 330 * MiB;
constexpr size_t WS_SPM = 339 * MiB;
constexpr size_t WS_END = 341 * MiB;
constexpr size_t PREG = (size_t)MT * 1024;
constexpr int TAB_BT = 0, TAB_LA0 = 16 * 3 * 132;

namespace pg8 {
#define PG8_LAS __attribute__((address_space(3)))
typedef unsigned short bf16_t;
typedef short bf16x8 __attribute__((ext_vector_type(8)));
typedef float f32x4 __attribute__((ext_vector_type(4)));
typedef unsigned u32x4 __attribute__((ext_vector_type(4)));
constexpr int BM = 256, BK = 64, HALF = 128, HTB = HALF * BK * 2  , STAGE_BYTES = 8 * HTB, NXCD = 8, WGM = 8;

__host__ __device__ __forceinline__ int lds_byte(int r, int c) { const int st = (r >> 4) * 2 + (c >> 5), rr = r & 15, cc = c & 31, ob = rr * 64 + cc * 2; return st * 1024 + (ob ^ (((ob >> 9) & 1) << 5)); }
__host__ __device__ __forceinline__ void stage_rc(int b, int& R, int& C) { const int st = b / 1024, sb = b % 1024, swz = sb ^ (((sb >> 9) & 1) << 5); R = (st >> 1) * 16 + swz / 64; C = (st & 1) * 32 + (swz % 64) / 2; }
__host__ __device__ __forceinline__ int perm32(int rho) { const int n = rho >> 4, i = rho & 15; return 8 * (i >> 2) + 4 * n + (i & 3); }

struct Unit { int pm, pn; };
struct Gemm { const bf16_t* A; const bf16_t* Bt; int M, N, K; };

struct StaticOrder {
    int nM, nN, nwg, G, c;
    __host__ __device__ void init(int M, int N, int G_, int c_) { nM = M / BM; nN = N / BM; nwg = nM * nN; G = G_; c = c_; }
    __host__ __device__ bool next(int i, Unit& u) const {
        const long L = (long)i * G + c; if (L >= nwg) return false;
        int wgid = (int)L; { const int q = nwg / NXCD, r = nwg % NXCD, xcd = wgid % NXCD, off = wgid / NXCD; wgid = (xcd < r ? xcd * (q + 1) : r * (q + 1) + (xcd - r) * q) + off; }
        const int nig = WGM * nN, gid = wgid / nig, fm = gid * WGM, gsz = (nM - fm) < WGM ? (nM - fm) : WGM;
        u.pm = fm + ((wgid % nig) % gsz); u.pn = (wgid % nig) / gsz; return true;
    }
    __device__ __forceinline__ void a_ready(const Unit&) const {}
    __device__ __forceinline__ void done(const Unit&) const {}
};

__device__ __forceinline__ unsigned cvt_pk_bf16(float lo, float hi) { unsigned r; asm volatile("v_cvt_pk_bf16_f32 %0, %1, %2" : "=v"(r) : "v"(lo), "v"(hi)); return r; }

struct EpiProj {
    static constexpr bool PERM = true, AFTER_DRAIN = false, MID = false;
    bf16_t* P; float* out;
    __device__ __forceinline__ void mid(f32x4 (&)[2][2][4][2], int, int, int) const {}
    __device__ __forceinline__ void operator()(const f32x4 (&acc)[2][2][4][2], const Unit& u, int ui, int wr, int wc, int fr, int fq) const {
        const int t = u.pn >> 2;
        const int colr = (u.pn & 3) * BM + wc * 32 + 8 * fq;
        const float sc = (t == 0) ? QSCALE : 1.f;
        bf16_t* base = P + (size_t)t * PREG;
        const bool smp = (u.pm == (MP / BM));
        float* fo = nullptr;
        if (t == 1) fo = out + (smp ? O_KS : O_KP); else if (t == 2) fo = out + (smp ? O_VS : O_VP);
        const int row0 = u.pm * BM + wr * 64 + fr;
#pragma unroll
        for (int ai = 0; ai < 2; ++ai)
#pragma unroll
            for (int m = 0; m < 4; ++m) {
                const int row = row0 + ai * HALF + m * 16;
                bf16_t* rowp = base + (size_t)row * 1024 + colr;
                size_t frow = (size_t)row;
                if (smp) { const int sr = row - MP; frow = (size_t)(sr >> 3) * 2048 + 2040 + (sr & 7); }
#pragma unroll
                for (int bj = 0; bj < 2; ++bj) {
                    const f32x4 a0 = acc[ai][bj][m][0], a1 = acc[ai][bj][m][1];
                    u32x4 w; w.x = cvt_pk_bf16(a0[0] * sc, a0[1] * sc); w.y = cvt_pk_bf16(a0[2] * sc, a0[3] * sc); w.z = cvt_pk_bf16(a1[0] * sc, a1[1] * sc); w.w = cvt_pk_bf16(a1[2] * sc, a1[3] * sc);
                    *(u32x4*)(rowp + bj * HALF) = w;
                    if (fo) { float* fp = fo + frow * 1024 + colr + bj * HALF; *(f32x4*)fp = a0; *(f32x4*)(fp + 4) = a1; }
                }
            }
    }
};

struct EpiOut {
    static constexpr bool PERM = false, AFTER_DRAIN = false, MID = true;
    const float* xp; const float* xs; float* out; const PG8_LAS float* rs;
    __device__ __forceinline__ void mid(f32x4 (&acc)[2][2][4][2], int ui, int wr, int fr) const {
        const PG8_LAS float* t = rs + (ui & 1) * 512;
#pragma unroll
        for (int ai = 0; ai < 2; ++ai)
#pragma unroll
            for (int m = 0; m < 4; ++m) { const float f = t[(ai * HALF + wr * 64 + m * 16 + fr) * 2];
#pragma unroll
                for (int bj = 0; bj < 2; ++bj)
#pragma unroll
                    for (int n = 0; n < 2; ++n) acc[ai][bj][m][n] = acc[ai][bj][m][n] * f; }
    }
    __device__ __forceinline__ void operator()(const f32x4 (&acc)[2][2][4][2], const Unit& u, int ui, int wr, int wc, int fr, int fq) const {
        const PG8_LAS float* t = rs + (ui & 1) * 512;
        const bool smp = (u.pm == (MP / BM));
        const int col0 = u.pn * BM + wc * 32 + 4 * fq;
#pragma unroll
        for (int ai = 0; ai < 2; ++ai)
#pragma unroll
            for (int m = 0; m < 4; ++m) {
                const int rl = ai * HALF + wr * 64 + m * 16 + fr, row = u.pm * BM + rl;
                const float f = t[rl * 2 + 1];
                const float* xr = smp ? xs + (size_t)(row - MP) * 1024 : xp + (size_t)row * 1024;
                float* orow = out + (size_t)row * 1024;
#pragma unroll
                for (int bj = 0; bj < 2; ++bj)
#pragma unroll
                    for (int n = 0; n < 2; ++n) { const int c = col0 + bj * HALF + n * 16; const f32x4 xv = *(const f32x4*)(xr + c); *(f32x4*)(orow + c) = xv + acc[ai][bj][m][n] * f; }
            }
    }
};

template <class Epi, class Sched, bool ALIGN_EPI = false, bool SP2 = false>
__device__ __forceinline__ void gemm_phase(PG8_LAS unsigned char* lds, const Gemm g, const Sched& S, const Epi& E) {
    const int tid = threadIdx.x, wid = __builtin_amdgcn_readfirstlane(tid >> 6), lane = tid & 63, wr = wid >> 2, wc = wid & 3, fr = lane & 15, fq = lane >> 4;
    const int K = g.K, nt = K / BK;
    unsigned voffA[2], voffB[2];
#pragma unroll
    for (int i = 0; i < 2; ++i) { int R, C; stage_rc(tid * 16 + i * 8192, R, C); const int Rb = Epi::PERM ? ((R & ~31) + perm32(R & 31)) : R;
        voffA[i] = (unsigned)(R * K + C) * 2u; voffB[i] = (unsigned)(Rb * K + C) * 2u; }
    const size_t kstep = (size_t)(BK * 2);
    const size_t hstep = (size_t)HALF * K * 2;
    const size_t tstep = 2 * hstep;
    const unsigned ldsw = (unsigned)wid * 1024u;
    const int aoff = lds_byte(wr * 64 + fr, fq * 8), boff = lds_byte(wc * 32 + fr, fq * 8);
#define PG8_SA(b, h) (((b) * 2 + (h)) * HTB)
#define PG8_SB(b, h) ((4 + (b) * 2 + (h)) * HTB)
#define PG8_STAGE(bufoff, gbase, voff) do { _Pragma("unroll") for (int _i = 0; _i < 2; ++_i) \
        __builtin_amdgcn_global_load_lds((const unsigned*)((const char*)(gbase) + (voff)[_i]), (PG8_LAS unsigned*)(lds + (bufoff) + ldsw + _i * 8192), 16, 0, 0); } while (0)
#define PG8_LDA(dst, b, h) do { _Pragma("unroll") for (int m = 0; m < 4; ++m) _Pragma("unroll") for (int k = 0; k < 2; ++k) dst[m][k] = *(const PG8_LAS bf16x8*)(lds + PG8_SA(b, h) + aoff + m * 2048 + k * 1024); } while (0)
#define PG8_LDB(dst, b, h) do { _Pragma("unroll") for (int n = 0; n < 2; ++n) _Pragma("unroll") for (int k = 0; k < 2; ++k) dst[n][k] = *(const PG8_LAS bf16x8*)(lds + PG8_SB(b, h) + boff + n * 2048 + k * 1024); } while (0)
#define PG8_MMA(ai, bj, At, Bt) do { __builtin_amdgcn_s_setprio(1); _Pragma("unroll") for (int m = 0; m < 4; ++m) _Pragma("unroll") for (int n = 0; n < 2; ++n) _Pragma("unroll") for (int k = 0; k < 2; ++k) \
        acc[ai][bj][m][n] = __builtin_amdgcn_mfma_f32_16x16x32_bf16(Bt[n][k], At[m][k], acc[ai][bj][m][n], 0, 0, 0); __builtin_amdgcn_s_setprio(0); } while (0)
#define PG8_WAIT_V(n) asm volatile("s_waitcnt vmcnt(" #n ")" ::: "memory")
#define PG8_WAIT_L(n) asm volatile("s_waitcnt lgkmcnt(" #n ")" ::: "memory")
#define PG8_BAR __builtin_amdgcn_s_barrier()
#define PG8_SCHED __builtin_amdgcn_sched_barrier(0)
    Unit cur, nxt; int ui = 0;
    if (!S.next(0, cur)) return;
    f32x4 acc[2][2][4][2];
#pragma unroll
    for (int a = 0; a < 2; ++a)
#pragma unroll
        for (int b = 0; b < 2; ++b)
#pragma unroll
            for (int m = 0; m < 4; ++m)
#pragma unroll
                for (int n = 0; n < 2; ++n) acc[a][b][m][n] = (f32x4){0.f, 0.f, 0.f, 0.f};
    bf16x8 At[4][2], B0[2][2], B1[2][2];
    const char* cA = (const char*)g.A + (size_t)cur.pm * tstep; const char* cB = (const char*)g.Bt + (size_t)cur.pn * tstep;
    S.a_ready(cur);
    if constexpr (SP2) {
        PG8_STAGE(PG8_SB(0, 0), cB, voffB); PG8_STAGE(PG8_SB(0, 1), cB + hstep, voffB); PG8_STAGE(PG8_SA(0, 0), cA, voffA); PG8_STAGE(PG8_SA(0, 1), cA + hstep, voffA);
        if (wr == 1) PG8_BAR;
        PG8_WAIT_V(2); PG8_BAR;
        PG8_STAGE(PG8_SB(1, 0), cB + kstep, voffB); PG8_STAGE(PG8_SA(1, 0), cA + kstep, voffA); PG8_STAGE(PG8_SB(1, 1), cB + hstep + kstep, voffB);
        PG8_WAIT_V(6); PG8_BAR;
    } else {
        PG8_STAGE(PG8_SB(0, 0), cB, voffB); PG8_STAGE(PG8_SA(0, 0), cA, voffA); PG8_STAGE(PG8_SB(0, 1), cB + hstep, voffB); PG8_STAGE(PG8_SA(0, 1), cA + hstep, voffA);
        if (wr == 1) PG8_BAR;
        PG8_WAIT_V(4); PG8_BAR;
        PG8_STAGE(PG8_SB(1, 0), cB + kstep, voffB); PG8_STAGE(PG8_SA(1, 0), cA + kstep, voffA); PG8_STAGE(PG8_SB(1, 1), cB + hstep + kstep, voffB);
        PG8_WAIT_V(6); PG8_BAR;
    }
    for (;;) {
        const bool has_next = S.next(ui + 1, nxt);
        const char* nA = has_next ? (const char*)g.A + (size_t)nxt.pm * tstep : cA; const char* nB = has_next ? (const char*)g.Bt + (size_t)nxt.pn * tstep : cB;
        for (int t = 0; t < nt; t += 2) {
            if constexpr (Epi::MID) { if (t == (nt >> 1)) E.mid(acc, ui, wr, fr); }
            const bool last = (t == nt - 2);
            const char* a1 = cA + (size_t)(t + 1) * kstep;
            const char* a2 = last ? nA : cA + (size_t)(t + 2) * kstep; const char* b2 = last ? nB : cB + (size_t)(t + 2) * kstep;
            const char* a3 = a2 + kstep; const char* b3 = b2 + kstep;
            if (last && has_next) S.a_ready(nxt);
            if constexpr (SP2) {
            PG8_LDB(B0, 0, 0); PG8_LDB(B1, 0, 1); PG8_SCHED; PG8_LDA(At, 0, 0); PG8_STAGE(PG8_SA(1, 1), a1 + hstep, voffA);
            PG8_WAIT_V(8); PG8_WAIT_L(0); PG8_BAR; PG8_MMA(0, 0, At, B0); PG8_MMA(0, 1, At, B1); PG8_BAR; PG8_SCHED;
            PG8_LDA(At, 0, 1); PG8_STAGE(PG8_SB(0, 0), b2, voffB); PG8_STAGE(PG8_SB(0, 1), b2 + hstep, voffB); PG8_STAGE(PG8_SA(0, 0), a2, voffA);
            PG8_WAIT_V(8); PG8_WAIT_L(0); PG8_BAR; PG8_MMA(1, 0, At, B0); PG8_MMA(1, 1, At, B1); PG8_BAR; PG8_SCHED;
            PG8_LDB(B0, 1, 0); PG8_LDB(B1, 1, 1); PG8_SCHED; PG8_LDA(At, 1, 0); PG8_STAGE(PG8_SA(0, 1), a2 + hstep, voffA);
            PG8_WAIT_V(8); PG8_WAIT_L(0); PG8_BAR; PG8_MMA(0, 0, At, B0); PG8_MMA(0, 1, At, B1); PG8_BAR; PG8_SCHED;
            PG8_LDA(At, 1, 1); PG8_STAGE(PG8_SB(1, 0), b3, voffB); PG8_STAGE(PG8_SB(1, 1), b3 + hstep, voffB); PG8_STAGE(PG8_SA(1, 0), a3, voffA);
            PG8_WAIT_V(8); PG8_WAIT_L(0); PG8_BAR; PG8_MMA(1, 0, At, B0); PG8_MMA(1, 1, At, B1); PG8_BAR; PG8_SCHED;
            } else {
            PG8_LDB(B0, 0, 0); PG8_SCHED; PG8_LDA(At, 0, 0); PG8_STAGE(PG8_SA(1, 1), a1 + hstep, voffA);
            PG8_WAIT_L(8); PG8_BAR; PG8_WAIT_L(0); PG8_MMA(0, 0, At, B0); PG8_BAR; PG8_SCHED;
            PG8_LDB(B1, 0, 1); PG8_STAGE(PG8_SB(0, 0), b2, voffB);
            PG8_BAR; PG8_WAIT_L(0); PG8_MMA(0, 1, At, B1); PG8_BAR;
            PG8_LDA(At, 0, 1); PG8_STAGE(PG8_SA(0, 0), a2, voffA);
            PG8_BAR; PG8_WAIT_L(0); PG8_MMA(1, 0, At, B0); PG8_BAR; PG8_SCHED;
            PG8_STAGE(PG8_SB(0, 1), b2 + hstep, voffB);
            PG8_WAIT_V(6); PG8_BAR; PG8_MMA(1, 1, At, B1); PG8_BAR;
            PG8_LDB(B0, 1, 0); PG8_SCHED; PG8_LDA(At, 1, 0); PG8_STAGE(PG8_SA(0, 1), a2 + hstep, voffA);
            PG8_WAIT_L(8); PG8_BAR; PG8_WAIT_L(0); PG8_MMA(0, 0, At, B0); PG8_BAR; PG8_SCHED;
            PG8_LDB(B1, 1, 1); PG8_STAGE(PG8_SB(1, 0), b3, voffB);
            PG8_BAR; PG8_WAIT_L(0); PG8_MMA(0, 1, At, B1); PG8_BAR;
            PG8_LDA(At, 1, 1); PG8_STAGE(PG8_SA(1, 0), a3, voffA);
            PG8_BAR; PG8_WAIT_L(0); PG8_MMA(1, 0, At, B0); PG8_BAR; PG8_SCHED;
            PG8_STAGE(PG8_SB(1, 1), b3 + hstep, voffB);
            PG8_WAIT_V(6); PG8_BAR; PG8_MMA(1, 1, At, B1); PG8_BAR;
            }
        }
        if constexpr (ALIGN_EPI) { if (wr == 0) PG8_BAR; }
        if constexpr (!Epi::AFTER_DRAIN) { E(acc, cur, ui, wr, wc, fr, fq); S.done(cur); }
        if (!has_next) break;
#pragma unroll
        for (int a = 0; a < 2; ++a)
#pragma unroll
            for (int b = 0; b < 2; ++b)
#pragma unroll
                for (int m = 0; m < 4; ++m)
#pragma unroll
                    for (int n = 0; n < 2; ++n) acc[a][b][m][n] = (f32x4){0.f, 0.f, 0.f, 0.f};
        cur = nxt; cA = nA; cB = nB; ++ui;
        if constexpr (ALIGN_EPI) { if (wr == 1) PG8_BAR; }
    }
    PG8_WAIT_V(0);
    if constexpr (!ALIGN_EPI) { if (wr == 0) PG8_BAR; }
    PG8_BAR;
    if constexpr (Epi::AFTER_DRAIN) { E.fused(acc, cur, wr, wc, fr, fq, lds, wid, lane); S.done(cur); }
#undef PG8_SA
#undef PG8_SB
#undef PG8_STAGE
#undef PG8_LDA
#undef PG8_LDB
#undef PG8_MMA
#undef PG8_WAIT_V
#undef PG8_WAIT_L
#undef PG8_BAR
#undef PG8_SCHED
}
}

#ifndef PG8_SP2
#define PG8_SP2 true
#endif
#ifndef PG8_ALIGN
#define PG8_ALIGN true
#endif

constexpr int NWAVES = 8;
constexpr int N_LAUNCHES = MK_N_LAUNCHES;
constexpr int PER_PHASE = 5;
constexpr int CW_TMO = 0, CW_CODE = 1;
constexpr int CW_BAR = 4096;
constexpr int CW_SCNT = 16384;
constexpr int RING_OFF = 0, RING_BYTES = 131072;
constexpr int LDSCTL_OFF = RING_BYTES, MISC_OFF = LDSCTL_OFF + 320;
constexpr int RS_OFF = RING_BYTES + 1024;
constexpr int LDS_BYTES = 147456;

#define GAS __attribute__((address_space(1)))
#define LAS __attribute__((address_space(3)))
typedef unsigned short bf16;
typedef unsigned v4u __attribute__((ext_vector_type(4)));
typedef unsigned v2u __attribute__((ext_vector_type(2)));
typedef float f32x4 __attribute__((ext_vector_type(4)));
typedef float f32x16 __attribute__((ext_vector_type(16)));
typedef short bf16x8 __attribute__((ext_vector_type(8)));
typedef short s16x4 __attribute__((ext_vector_type(4)));
typedef GAS unsigned gu32;
typedef GAS unsigned long long gu64;
#define RLX_AGENT __ATOMIC_RELAXED, __HIP_MEMORY_SCOPE_AGENT
#define LDS_WAIT() asm volatile("s_waitcnt lgkmcnt(0)" ::: "memory")
#define VM_WAIT() asm volatile("s_waitcnt vmcnt(0)" ::: "memory")
__device__ __forceinline__ unsigned f2bf(float f) { unsigned u = __builtin_bit_cast(unsigned, f); return (u + 0x7fffu + ((u >> 16) & 1u)) >> 16; }
__device__ __forceinline__ unsigned pk2(float lo, float hi) { return f2bf(lo) | (f2bf(hi) << 16); }
__device__ __forceinline__ float bflo(unsigned w) { return __builtin_bit_cast(float, w << 16); }
__device__ __forceinline__ float bfhi(unsigned w) { return __builtin_bit_cast(float, w & 0xffff0000u); }
__device__ __forceinline__ float bf1(unsigned short h) { return __builtin_bit_cast(float, (unsigned)h << 16); }
__device__ __forceinline__ float ex2(float x) { return __builtin_amdgcn_exp2f(x); }
__device__ __forceinline__ float lg2(float x) { return __builtin_amdgcn_logf(x); }
__device__ __forceinline__ float rcpf_(float x) { return __builtin_amdgcn_rcpf(x); }
__device__ __forceinline__ float sigmoidf_(float x) { return rcpf_(1.f + ex2(-x * LOG2E)); }
__device__ __forceinline__ float siluf_(float x) { return x * sigmoidf_(x); }

#define XB_TMO      128
#define XB_XCNT(j)  (256  + 64 * (j))
#define XB_XSUB(j)  (1280 + 64 * (j))
#define XB_XGEN(j)  (2304 + 64 * (j))
#define XB_TOP      3328
#define XB_TOPGEN   3392
#define XCD_BAR_WORDS 3456
#define XB_SPIN_CAP (1u << 18)

__device__ __forceinline__ unsigned xb_ld(unsigned* p)              { return __hip_atomic_load(p, __ATOMIC_RELAXED, __HIP_MEMORY_SCOPE_AGENT); }
__device__ __forceinline__ unsigned xb_add(unsigned* p, unsigned v) { return __hip_atomic_fetch_add(p, v, __ATOMIC_RELAXED, __HIP_MEMORY_SCOPE_AGENT); }
__device__ __forceinline__ unsigned xb_xcc_id() { return (unsigned)__builtin_amdgcn_s_getreg((3 << 11) | 20) & 0xFu; }
#define XB_SPIN(cond, bar) do { unsigned _sp = 0; while (cond) { __builtin_amdgcn_s_sleep(1); \
    if ((++_sp & 255u) == 0u) { if (xb_ld(&(bar)[XB_TMO])) break; if (_sp > XB_SPIN_CAP) { atomicAdd(&(bar)[XB_TMO], 1u); break; } } } } while (0)

struct XcdBarrier {
    unsigned* bar; unsigned x;
    volatile LAS unsigned* st;
};

__device__ __forceinline__ XcdBarrier xcd_barrier_post(unsigned* bar, volatile LAS unsigned* st) {
    XcdBarrier b; b.bar = bar; b.x = xb_xcc_id(); b.st = st;
    if (threadIdx.x == 0) (void)xb_add(&bar[XB_XCNT(b.x)], 1u);
    return b;
}
__device__ __forceinline__ void xcd_barrier_complete(unsigned* bar, unsigned x, unsigned& nloc, unsigned& nx) {
    const unsigned G = gridDim.x * gridDim.y * gridDim.z;
    unsigned sum, cnt, mine, sp = 0u;
    for (;;) {
        sum = 0u; cnt = 0u; mine = 0u;
#pragma unroll
        for (unsigned j = 0; j < 16; ++j) { const unsigned c = xb_ld(&bar[XB_XCNT(j)]); sum += c; cnt += (c > 0u) ? 1u : 0u; mine = (j == x) ? c : mine; }
        if (sum == G) break;
        __builtin_amdgcn_s_sleep(1);
        if ((++sp & 255u) == 0u) { if (xb_ld(&bar[XB_TMO])) break; if (sp > XB_SPIN_CAP) { atomicAdd(&bar[XB_TMO], 1u); break; } }
    }
    nloc = mine > 0u ? mine : 1u; nx = cnt > 0u ? cnt : 1u;
}

__device__ __forceinline__ void xcd_barrier(const XcdBarrier& b) {
    asm volatile("s_waitcnt vmcnt(0)" ::: "memory");
    __syncthreads();
    if (threadIdx.x == 0) {
        unsigned* bar = b.bar;
        __builtin_amdgcn_s_waitcnt(0);
        unsigned nloc = b.st[0], nx = b.st[1];
        if (nloc == 0u) { xcd_barrier_complete(bar, b.x, nloc, nx); b.st[0] = nloc; b.st[1] = nx; }
        const unsigned old = xb_add(&bar[XB_XSUB(b.x)], 1u);
        const unsigned gen = old / nloc;
        if (old + 1u == (gen + 1u) * nloc) {
            __builtin_amdgcn_fence(__ATOMIC_RELEASE, "agent");
            asm volatile("s_waitcnt vmcnt(0)" ::: "memory");
            const unsigned og = xb_add(&bar[XB_TOP], 1u);
            const unsigned tg = og / nx;
            if (og + 1u == (tg + 1u) * nx) xb_add(&bar[XB_TOPGEN], 1u);
            else XB_SPIN(xb_ld(&bar[XB_TOPGEN]) == tg, bar);
            __builtin_amdgcn_fence(__ATOMIC_ACQUIRE, "agent");
            xb_add(&bar[XB_XGEN(b.x)], 1u);
            asm volatile("s_waitcnt vmcnt(0)" ::: "memory");
        } else {
            XB_SPIN(xb_ld(&bar[XB_XGEN(b.x)]) == gen, bar);
            __builtin_amdgcn_fence(__ATOMIC_ACQUIRE, "agent");
            asm volatile("s_waitcnt vmcnt(0)" ::: "memory");
        }
    }
    __syncthreads();
}

struct Args { const float* in[20]; float* out; unsigned char* ws; int ph_lo, ph_hi, li, pad; };
struct Frame {
    LAS unsigned char* lds;
    volatile LAS unsigned* MISC;
    gu32* ctl;
    int tid, lane, wave;
    int vcu, G;
    float* out;
    unsigned char* ws;
};
__device__ __forceinline__ float wave_sum(float v) {
#pragma unroll
    for (int o = 1; o < 64; o <<= 1) v += __shfl_xor(v, o);
    return v;
}

__device__ __forceinline__ void p0_transpose_item(const float* W, int K, int N, bf16* WT, LAS float* scr, int item, int lane) {
    const int nblk = N / 32, kb = item / nblk, nb = item % nblk, k0 = 64 * kb, n0 = 32 * nb;
#pragma unroll 8
    for (int i = 0; i < 32; ++i) { const int kk = 2 * i + (lane >> 5); scr[kk * 33 + (lane & 31)] = W[(size_t)(k0 + kk) * N + n0 + (lane & 31)]; }
    LDS_WAIT(); asm volatile("" ::: "memory");
    const int c = lane & 7;
#pragma unroll
    for (int j = 0; j < 4; ++j) { const int n = (lane >> 3) + 8 * j; const LAS float* s = scr + (8 * c) * 33 + n;
        v4u o; o.x = pk2(s[0 * 33], s[1 * 33]); o.y = pk2(s[2 * 33], s[3 * 33]); o.z = pk2(s[4 * 33], s[5 * 33]); o.w = pk2(s[6 * 33], s[7 * 33]);
        *(GAS v4u*)(WT + (size_t)(n0 + n) * K + k0 + 8 * c) = o; }
    LDS_WAIT(); asm volatile("" ::: "memory");
}
__device__ __forceinline__ int t5_bucket(int d) {
    if (d < 16) return d;
    int b = 15;
    const int thr[16] = {16, 22, 30, 40, 54, 73, 99, 134, 182, 246, 332, 450, 609, 825, 1117, 1513};
#pragma unroll
    for (int i = 0; i < 16; ++i) b += (d >= thr[i]) ? 1 : 0;
    return b;
}
__device__ __forceinline__ void p0_prologue(Frame& F, const Args& A) {
    LAS float* scr = (LAS float*)(F.lds + RING_OFF + F.wave * 16384);
    const int gw = F.vcu * NWAVES + F.wave, NGW = F.G * NWAVES;
    constexpr int I_IN = (DM / 64) * (NPROJ / 32), I_OUT = (DMIX / 64) * (DM / 32), I_G = 16 * 2;
    constexpr int NITEMS = I_IN + I_OUT + 2 * I_G;
    bf16* WIN = (bf16*)(F.ws + WS_WIN); bf16* WOUT = (bf16*)(F.ws + WS_WOUT); bf16* WG = (bf16*)(F.ws + WS_WG);
    for (int it = gw; it < NITEMS; it += NGW) {
        int r = it;
        if (r < I_IN) { p0_transpose_item(A.in[8], DM, NPROJ, WIN, scr, r, F.lane); continue; } r -= I_IN;
        if (r < I_OUT) { p0_transpose_item(A.in[18], DMIX, DM, WOUT, scr, r, F.lane); continue; } r -= I_OUT;
        if (r < I_G) { const int blk = r >> 1; p0_transpose_item(A.in[13] + blk * 4096, 64, 64, WG + (blk * 2 + 0) * 4096, scr, r & 1, F.lane); continue; } r -= I_G;
        { const int blk = r >> 1; p0_transpose_item(A.in[15] + blk * 4096, 64, 64, WG + (blk * 2 + 1) * 4096, scr, r & 1, F.lane); }
    }
    bf16* XN = (bf16*)(F.ws + WS_XN);
    const GAS f32x4* gin = (const GAS f32x4*)A.in[7] + F.lane;
    for (int m = gw; m < MT; m += NGW) {
        const float* xrow = (m < MP) ? A.in[0] + (size_t)m * DM : A.in[1] + (size_t)(m - MP) * DM;
        const GAS f32x4* xr = (const GAS f32x4*)xrow + F.lane;
        f32x4 v[4]; float s = 0.f;
#pragma unroll
        for (int j = 0; j < 4; ++j) { v[j] = xr[64 * j]; s += (v[j].x * v[j].x + v[j].y * v[j].y) + (v[j].z * v[j].z + v[j].w * v[j].w); }
        const float rstd = 1.f / sqrtf(wave_sum(s) * (1.f / DM) + EPS);
        GAS unsigned long long* o8 = (GAS unsigned long long*)(XN + (size_t)m * DM) + F.lane;
#pragma unroll
        for (int j = 0; j < 4; ++j) { const f32x4 g = gin[64 * j];
            o8[64 * j] = (unsigned long long)pk2(v[j].x * rstd * g.x, v[j].y * rstd * g.y) | ((unsigned long long)pk2(v[j].z * rstd * g.z, v[j].w * rstd * g.w) << 32); }
    }
    float* TAB = (float*)(F.ws + WS_TAB);
    const int gt = F.vcu * (NWAVES * 64) + F.tid, NGT = F.G * NWAVES * 64;
    for (int i = gt; i < 16 * 3 * 132; i += NGT) {
        const int h = i / 396, rem = i % 396, p = rem / 132, s = rem % 132;
        const int sc = s > 128 ? 128 : s;
        TAB[TAB_BT + i] = A.in[6][t5_bucket(sc << (2 * p)) * 16 + h] * LOG2E;
    }
    for (int i = gt; i < 1024; i += NGT) {
        const float x = -A.in[17][i];
        TAB[TAB_LA0 + i] = -8.f * (fmaxf(x, 0.f) + log1pf(expf(-fabsf(x))));
    }
}


namespace att {
constexpr int A_ACCO = 0;
constexpr int A_ACCL = 32768;
constexpr int A_BT = 33792;
constexpr int A_WS = 35840;
constexpr int A_KV = 40960;
constexpr int A_END = A_KV + 8 * 8192;
constexpr float THR = 8.0f;
__device__ __forceinline__ int crow(int r, int hi) { return (r & 3) + 8 * (r >> 2) + 4 * hi; }
typedef short v4i16_t __attribute__((ext_vector_type(4)));
__device__ __forceinline__ s16x4 vtr(const LAS unsigned char* p) { return __builtin_bit_cast(s16x4, __builtin_amdgcn_ds_read_tr16_b64_v4i16((LAS v4i16_t*)p)); }
typedef float f32x2_t __attribute__((ext_vector_type(2))); typedef __bf16 bf16x2_t __attribute__((ext_vector_type(2)));
__device__ __forceinline__ unsigned cvtpk(float lo, float hi) { f32x2_t v = {lo, hi}; bf16x2_t b = __builtin_convertvector(v, bf16x2_t); return __builtin_bit_cast(unsigned, b); }

struct Geo { int dil, im, hb, res; };
__device__ __forceinline__ int tok_of(const Geo& g, int p0, int i) { return g.dil * (p0 + (i & g.im)) + g.res + ((i >> 4) & g.hb); }

struct WaveState { f32x16 o0, o1; float m, l; };

__device__ __forceinline__ void tile(WaveState& st, const bf16x8 (&qr)[4], const bf16* Kh, const bf16* Vh, const Geo& g, int kp0, int sbase,
                                     LAS unsigned char* Kw, LAS unsigned char* Vw, LAS float* wsf, const LAS float* bt, int lane) {
    const int r32 = lane & 31, hi = lane >> 5;
    asm volatile("" ::: "memory");
#pragma unroll
    for (int i = 0; i < 4; ++i) {
        const int row = 8 * i + (lane >> 3), cp = lane & 7;
        const size_t tk = (size_t)tok_of(g, kp0, row) * 1024;
        const int ck = cp ^ ((row >> 1) & 7), cv = cp ^ (((row >> 1) & 1) << 2);
        __builtin_amdgcn_global_load_lds((const unsigned*)(Kh + tk + ck * 8), (LAS unsigned*)(Kw + i * 1024), 16, 0, 0);
        __builtin_amdgcn_global_load_lds((const unsigned*)(Vh + tk + cv * 8), (LAS unsigned*)(Vw + i * 1024), 16, 0, 0);
    }
    asm volatile("s_waitcnt vmcnt(0)" ::: "memory");
    f32x16 S = {0.f, 0.f, 0.f, 0.f, 0.f, 0.f, 0.f, 0.f, 0.f, 0.f, 0.f, 0.f, 0.f, 0.f, 0.f, 0.f};
    const LAS unsigned char* kb = Kw + r32 * 128;
    const int ksw = (r32 >> 1) & 7;
#pragma unroll
    for (int ks = 0; ks < 4; ++ks) {
        const bf16x8 kf = *(const LAS bf16x8*)(kb + (((2 * ks + hi) ^ ksw) << 4));
        S = __builtin_amdgcn_mfma_f32_32x32x16_bf16(kf, qr[ks], S, 0, 0, 0);
    }
    {
        const int sq = sbase + (r32 & g.im);
        const int qh = (r32 >> 4) & g.hb;
#pragma unroll
        for (int r = 0; r < 16; ++r) {
            const int kk = crow(r, hi);
            const int s = sq - (kk & g.im);
            const bool valid = ((unsigned)s <= 128u) && ((((kk >> 4) & g.hb)) == qh);
            const int sc = s < 0 ? 0 : (s > 128 ? 128 : s);
            const float v = S[r] + bt[sc];
            S[r] = valid ? v : -INFINITY;
        }
    }
    float mx = S[0];
#pragma unroll
    for (int r = 1; r < 16; ++r) mx = fmaxf(mx, S[r]);
    mx = fmaxf(mx, __shfl_xor(mx, 32));
    if (__any(mx > st.m + THR)) {
        const float mn = fmaxf(st.m, mx);
        const float al = ex2(st.m - mn);
        st.l *= al; st.m = mn;
        if (hi == 0) wsf[r32] = al;
        LDS_WAIT();
#pragma unroll
        for (int r = 0; r < 16; ++r) { const float f = wsf[crow(r, hi)]; st.o0[r] *= f; st.o1[r] *= f; }
    }
    float ps = 0.f;
#pragma unroll
    for (int r = 0; r < 16; ++r) { S[r] = ex2(S[r] - st.m); ps += S[r]; }
    st.l += ps;
    const int g16 = lane >> 4, i16 = lane & 15, q4 = i16 >> 2, p4 = i16 & 3;
    const LAS unsigned char* vb = Vw + (4 * hi + q4) * 128 + (((2 * (g16 & 1)) + (p4 >> 1)) << 4) + 8 * (p4 & 1);
    const int xo = (q4 >> 1) * 64;
#pragma unroll
    for (int ks = 0; ks < 2; ++ks) {
        v4u pw; pw.x = cvtpk(S[8 * ks + 0], S[8 * ks + 1]); pw.y = cvtpk(S[8 * ks + 2], S[8 * ks + 3]); pw.z = cvtpk(S[8 * ks + 4], S[8 * ks + 5]); pw.w = cvtpk(S[8 * ks + 6], S[8 * ks + 7]);
        const bf16x8 pa = __builtin_bit_cast(bf16x8, pw);
        const s16x4 a0 = vtr(vb + ks * 2048 + (0 ^ xo)), a1 = vtr(vb + ks * 2048 + 1024 + (0 ^ xo));
        const s16x4 b0 = vtr(vb + ks * 2048 + (64 ^ xo)), b1 = vtr(vb + ks * 2048 + 1024 + (64 ^ xo));
        const bf16x8 v0 = (bf16x8){a0[0], a0[1], a0[2], a0[3], a1[0], a1[1], a1[2], a1[3]};
        const bf16x8 v1 = (bf16x8){b0[0], b0[1], b0[2], b0[3], b1[0], b1[1], b1[2], b1[3]};
        st.o0 = __builtin_amdgcn_mfma_f32_32x32x16_bf16(pa, v0, st.o0, 0, 0, 0);
        st.o1 = __builtin_amdgcn_mfma_f32_32x32x16_bf16(pa, v1, st.o1, 0, 0, 0);
    }
    asm volatile("" ::: "memory");
}

__device__ __forceinline__ void merge(LAS unsigned char* base, const WaveState& st, int tl, bool first, bool keep_l, int w, int lane) {
    const int r32 = lane & 31, hi = lane >> 5;
    LAS float* wsf = (LAS float*)(base + A_WS) + w * 128;
    LAS float* accL = (LAS float*)(base + A_ACCL);
    LAS unsigned short* accO = (LAS unsigned short*)(base + A_ACCO);
    const float lt = st.l + __shfl_xor(st.l, 32);
    const float lse = st.m + lg2(lt);
    const float rl = rcpf_(lt);
    float wA = 0.f, wB = rl, lnew = lse;
    if (!first) { const float la = accL[tl]; const float M = fmaxf(la, lse); const float ea = ex2(la - M), eb = ex2(lse - M); const float sm = ea + eb; lnew = M + lg2(sm); const float inv = rcpf_(sm); wA = ea * inv; wB = eb * inv * rl; }
    if (hi == 0) { wsf[r32] = wA; wsf[32 + r32] = wB; ((LAS int*)wsf)[64 + r32] = tl; if (keep_l) accL[tl] = lnew; }
    LDS_WAIT();
#pragma unroll
    for (int r = 0; r < 16; ++r) {
        const int q = crow(r, hi);
        const float a = wsf[q], b = wsf[32 + q]; const int tq = ((LAS int*)wsf)[64 + q];
        LAS unsigned short* p0 = accO + tq * 64 + r32;
        float n0 = b * st.o0[r], n1 = b * st.o1[r];
        if (!first) { n0 += a * bf1(p0[0]); n1 += a * bf1(p0[32]); }
        p0[0] = (unsigned short)f2bf(n0); p0[32] = (unsigned short)f2bf(n1);
    }
}

__device__ __forceinline__ void attn_unit(Frame& F, const Args& A, int b, int h, int J) {
    LAS unsigned char* base = F.lds + RING_OFF;
    const int lane = F.lane, w = F.wave, r32 = lane & 31, hi = lane >> 5;
    const bf16* P = (const bf16*)(F.ws + WS_P);
    const size_t rowb = (size_t)b * SEQ;
    const bf16* Qh = P + 0 * PREG + rowb * 1024 + h * 64;
    const bf16* Kh = P + 1 * PREG + rowb * 1024 + h * 64;
    const bf16* Vh = P + 2 * PREG + rowb * 1024 + h * 64;
    { const float* TAB = (const float*)(F.ws + WS_TAB) + TAB_BT + h * 396; LAS float* bt = (LAS float*)(base + A_BT);
      if (F.tid < 396) bt[F.tid] = TAB[F.tid]; }
    __syncthreads();
    LAS unsigned char* Kw = base + A_KV + w * 8192; LAS unsigned char* Vw = Kw + 4096;
    LAS float* wsf = (LAS float*)(base + A_WS) + w * 128;
#pragma unroll 1
    for (int pat = 0; pat < 3; ++pat) {
        Geo g; int qp0, tl;
        if (pat == 0)      { g.dil = 16; g.im = 15; g.hb = 1; g.res = 2 * w;  qp0 = 16 * J;                 tl = 16 * (r32 & 15) + 2 * w + (r32 >> 4); }
        else if (pat == 1) { g.dil = 4;  g.im = 31; g.hb = 0; g.res = w & 3;  qp0 = 64 * J + 32 * (w >> 2); tl = 4 * (32 * (w >> 2) + r32) + (w & 3); }
        else               { g.dil = 1;  g.im = 31; g.hb = 0; g.res = 0;      qp0 = 256 * J + 32 * w;       tl = 32 * w + r32; }
        const LAS float* bt = (const LAS float*)(base + A_BT) + (2 - pat) * 132;
        bf16x8 qr[4];
        { const bf16* qrow = Qh + (size_t)tok_of(g, qp0, r32) * 1024 + 8 * hi;
#pragma unroll
          for (int ks = 0; ks < 4; ++ks) qr[ks] = *(const bf16x8*)(qrow + 16 * ks); }
        WaveState st; st.m = -INFINITY; st.l = 0.f;
#pragma unroll
        for (int r = 0; r < 16; ++r) { st.o0[r] = 0.f; st.o1[r] = 0.f; }
        int kp, kend, kstep, sb;
        if (pat == 0) { kp = 0; kend = 16 * J; kstep = 16; sb = 16 * J; }
        else { kp = qp0 - 128; kend = qp0; kstep = 32; sb = 128; if (kp < 0) { sb += kp; kp = 0; } }
#pragma unroll 1
        for (; kp <= kend; kp += kstep, sb -= kstep) tile(st, qr, Kh, Vh, g, kp, sb, Kw, Vw, wsf, bt, lane);
        merge(base, st, tl, pat == 0, pat < 2, w, lane);
        if (pat < 2) __syncthreads();
    }
    LDS_WAIT(); asm volatile("" ::: "memory");
    const int c8 = lane & 7;
    const LAS unsigned char* accO = base + A_ACCO;
    const bf16* GA = P + 3 * PREG; bf16* Y = (bf16*)(F.ws + WS_Y); float* SSQ = (float*)(F.ws + WS_SSQ);
    const float* nw = A.in[9] + h * 64 + 8 * c8;
    const f32x4 nw0 = *(const f32x4*)nw, nw1 = *(const f32x4*)(nw + 4);
#pragma unroll
    for (int i = 0; i < 4; ++i) {
        const int tloc = 32 * w + 8 * i + (lane >> 3);
        const size_t m = rowb + 256 * J + tloc;
        const v4u ov = *(const LAS v4u*)(accO + tloc * 128 + c8 * 16);
        const v4u gv = *(const v4u*)(GA + m * 1024 + h * 64 + 8 * c8);
        float o[8] = {bflo(ov.x), bfhi(ov.x), bflo(ov.y), bfhi(ov.y), bflo(ov.z), bfhi(ov.z), bflo(ov.w), bfhi(ov.w)};
        float gg[8] = {bflo(gv.x), bfhi(gv.x), bflo(gv.y), bfhi(gv.y), bflo(gv.z), bfhi(gv.z), bflo(gv.w), bfhi(gv.w)};
        float ss = 0.f;
#pragma unroll
        for (int k = 0; k < 8; ++k) ss += o[k] * o[k];
        ss += __shfl_xor(ss, 1); ss += __shfl_xor(ss, 2); ss += __shfl_xor(ss, 4);
        if (c8 == 0) SSQ[m * 32 + h] = ss;
        float y[8];
#pragma unroll
        for (int k = 0; k < 8; ++k) y[k] = o[k] * siluf_(gg[k]) * (k < 4 ? nw0[k] : nw1[k - 4]);
        v4u yo; yo.x = pk2(y[0], y[1]); yo.y = pk2(y[2], y[3]); yo.z = pk2(y[4], y[5]); yo.w = pk2(y[6], y[7]);
        *(v4u*)(Y + m * 2048 + h * 64 + 8 * c8) = yo;
    }
    __syncthreads();
}
}


namespace lru {
constexpr int L_XCS = 0;
constexpr int L_XCF = 16384;
constexpr int L_AB = 49152;
constexpr int TC = 128;
typedef float f32x2_t __attribute__((ext_vector_type(2)));

__device__ __forceinline__ void lru_unit(Frame& F, const Args& A, int cb, int R0, int nrows, int TSEG, bool smp, int bidx0) {
    LAS unsigned char* base = F.lds + RING_OFF;
    const int tid = F.tid, lane = F.lane, w = F.wave;
    const bf16* P = (const bf16*)(F.ws + WS_P);
    const bf16* XR = P + 4 * PREG + cb * 64; const bf16* GR = P + 5 * PREG + cb * 64;
    bf16* Y = (bf16*)(F.ws + WS_Y) + 1024 + cb * 64; float* SSQ = (float*)(F.ws + WS_SSQ);
    const float* TAB = (const float*)(F.ws + WS_TAB);
    const int ch0 = cb * 64;
    const int prow = tid >> 2, pq = tid & 3;
    float hcar = 0.f;
    const int nchunk = nrows / TC;
    for (int c = 0; c < nchunk; ++c) {
        const int r0 = c * TC;
#pragma unroll 1
        for (int hp = 0; hp < 2; ++hp) {
            const int rr = r0 + prow, tin = rr % TSEG, bi = bidx0 + rr / TSEG;
            const size_t m = (size_t)R0 + rr;
            const int c8 = 16 * pq + 8 * hp;
            float xv[4][8];
#pragma unroll
            for (int k = 0; k < 4; ++k) {
                const int back = 3 - k;
                if (tin >= back) {
                    const v4u a = *(const v4u*)(XR + (m - back) * 1024 + c8);
                    xv[k][0] = bflo(a.x); xv[k][1] = bfhi(a.x); xv[k][2] = bflo(a.y); xv[k][3] = bfhi(a.y); xv[k][4] = bflo(a.z); xv[k][5] = bfhi(a.z); xv[k][6] = bflo(a.w); xv[k][7] = bfhi(a.w);
                } else if (smp) {
                    const float* cp = A.in[4] + ((size_t)bi * 3 + (3 + tin - back)) * 1024 + ch0 + c8;
#pragma unroll
                    for (int j = 0; j < 8; ++j) xv[k][j] = cp[j];
                } else {
#pragma unroll
                    for (int j = 0; j < 8; ++j) xv[k][j] = 0.f;
                }
            }
            const float* cw = A.in[11] + ch0 + c8; const float* cbias = A.in[12] + ch0 + c8;
            float xc[8];
#pragma unroll
            for (int j = 0; j < 8; ++j) xc[j] = cbias[j] + cw[j] * xv[0][j] + cw[1024 + j] * xv[1][j] + cw[2048 + j] * xv[2][j] + cw[3072 + j] * xv[3][j];
            if (tin >= TSEG - 3) {
                float* co = F.out + (smp ? O_CS : O_CP) + ((size_t)bi * 3 + (tin - (TSEG - 3))) * 1024 + ch0 + c8;
                *(f32x4*)(co) = (f32x4){xv[3][0], xv[3][1], xv[3][2], xv[3][3]}; *(f32x4*)(co + 4) = (f32x4){xv[3][4], xv[3][5], xv[3][6], xv[3][7]};
            }
            LAS float* xf = (LAS float*)(base + L_XCF) + prow * 64 + c8;
            *(LAS f32x4*)(xf) = (f32x4){xc[0], xc[1], xc[2], xc[3]}; *(LAS f32x4*)(xf + 4) = (f32x4){xc[4], xc[5], xc[6], xc[7]};
            const int sw = (prow >> 1) & 7;
            v4u s0; s0.x = pk2(xc[0], xc[1]); s0.y = pk2(xc[2], xc[3]); s0.z = pk2(xc[4], xc[5]); s0.w = pk2(xc[6], xc[7]);
            *(LAS v4u*)(base + L_XCS + prow * 128 + (((2 * pq + hp) ^ sw) << 4)) = s0;
        }
        __syncthreads();
        {
            bf16x8 wb[2][4][2];
            { const bf16* WG = (const bf16*)(F.ws + WS_WG) + (size_t)cb * 2 * 4096;
#pragma unroll
              for (int g = 0; g < 2; ++g)
#pragma unroll
                for (int n = 0; n < 4; ++n)
#pragma unroll
                    for (int ks = 0; ks < 2; ++ks) wb[g][n][ks] = *(const bf16x8*)(WG + g * 4096 + (16 * n + (lane & 15)) * 64 + 32 * ks + 8 * (lane >> 4)); }
            const int arow = 16 * w + (lane & 15), g4 = lane >> 4, sw = (arow >> 1) & 7;
            bf16x8 af[2];
#pragma unroll
            for (int ks = 0; ks < 2; ++ks) af[ks] = *(const LAS bf16x8*)(base + L_XCS + arow * 128 + (((4 * ks + g4) ^ sw) << 4));
            const LAS float* xf = (const LAS float*)(base + L_XCF);
            LAS f32x2_t* ab = (LAS f32x2_t*)(base + L_AB);
#pragma unroll
            for (int n = 0; n < 4; ++n) {
                f32x4 ax = {0.f, 0.f, 0.f, 0.f}, aa = {0.f, 0.f, 0.f, 0.f};
#pragma unroll
                for (int ks = 0; ks < 2; ++ks) { ax = __builtin_amdgcn_mfma_f32_16x16x32_bf16(af[ks], wb[0][n][ks], ax, 0, 0, 0); aa = __builtin_amdgcn_mfma_f32_16x16x32_bf16(af[ks], wb[1][n][ks], aa, 0, 0, 0); }
                const int cl = 16 * n + (lane & 15), cg = ch0 + cl;
                const float bgx = A.in[14][cg], bga = A.in[16][cg], la0 = TAB[TAB_LA0 + cg];
#pragma unroll
                for (int rg = 0; rg < 4; ++rg) {
                    const int row = 16 * w + 4 * g4 + rg;
                    const float gx = sigmoidf_(ax[rg] + bgx), ga = sigmoidf_(aa[rg] + bga);
                    const float l2a = ga * la0 * LOG2E;
                    const float a = ex2(l2a);
                    const float mult = sqrtf(fmaxf(1.f - ex2(2.f * l2a), 0.f));
                    ab[row * 64 + cl] = (f32x2_t){a, mult * gx * xf[row * 64 + cl]};
                }
            }
        }
        __syncthreads();
        if (w == 0) {
            const LAS f32x2_t* ab = (const LAS f32x2_t*)(base + L_AB);
            LAS float* hs = (LAS float*)(base + L_XCF);
            int tin = r0 % TSEG, bi = bidx0 + r0 / TSEG;
#pragma unroll 8
            for (int r = 0; r < TC; ++r) {
                if (tin == 0) hcar = smp ? A.in[5][(size_t)bi * 1024 + ch0 + lane] : 0.f;
                const f32x2_t v = ab[r * 64 + lane];
                hcar = v.x * hcar + v.y;
                hs[r * 64 + lane] = hcar;
                if (++tin == TSEG) { F.out[(smp ? O_LS : O_LP) + (size_t)bi * 1024 + ch0 + lane] = hcar; tin = 0; ++bi; }
            }
        }
        __syncthreads();
        {
            const size_t m = (size_t)R0 + r0 + prow;
            const LAS float* hs = (const LAS float*)(base + L_XCF) + prow * 64 + 16 * pq;
            const v4u ga = *(const v4u*)(GR + m * 1024 + 16 * pq), gb = *(const v4u*)(GR + m * 1024 + 16 * pq + 8);
            const float g[16] = {bflo(ga.x), bfhi(ga.x), bflo(ga.y), bfhi(ga.y), bflo(ga.z), bfhi(ga.z), bflo(ga.w), bfhi(ga.w), bflo(gb.x), bfhi(gb.x), bflo(gb.y), bfhi(gb.y), bflo(gb.z), bfhi(gb.z), bflo(gb.w), bfhi(gb.w)};
            const float* nw = A.in[10] + ch0 + 16 * pq;
            float y[16], ss = 0.f;
#pragma unroll
            for (int j = 0; j < 16; ++j) { const float hv = hs[j]; ss += hv * hv; y[j] = hv * siluf_(g[j]) * nw[j]; }
            ss += __shfl_xor(ss, 1); ss += __shfl_xor(ss, 2);
            if (pq == 0) SSQ[m * 32 + 16 + cb] = ss;
            v4u y0, y1;
            y0.x = pk2(y[0], y[1]); y0.y = pk2(y[2], y[3]); y0.z = pk2(y[4], y[5]); y0.w = pk2(y[6], y[7]);
            y1.x = pk2(y[8], y[9]); y1.y = pk2(y[10], y[11]); y1.z = pk2(y[12], y[13]); y1.w = pk2(y[14], y[15]);
            *(v4u*)(Y + m * 2048 + 16 * pq) = y0; *(v4u*)(Y + m * 2048 + 16 * pq + 8) = y1;
        }
        __syncthreads();
    }
}
}

__device__ __forceinline__ void copy_phase(Frame& F, const Args& A) {
    constexpr unsigned SEG4 = 2040u * 256u;
    constexpr unsigned N4 = 64u * SEG4;
    const unsigned per = (N4 + (unsigned)F.G - 1u) / (unsigned)F.G;
    const unsigned lo = (unsigned)F.vcu * per, hi = (lo + per < N4) ? lo + per : N4;
    const float* ck = A.in[2]; const float* cv = A.in[3];
    for (unsigned i0 = lo + (unsigned)F.tid; i0 < hi; i0 += 4u * NWAVES * 64) {
        f32x4 v0, v1, v2, v3;
#define CP_LD(vv, u) { const unsigned ix = i0 + (u) * NWAVES * 64u; if (ix < hi) { const unsigned zb = ix / SEG4, off = ix - zb * SEG4; const unsigned b = zb & 31u; \
            const f32x4* src = (const f32x4*)(((zb >> 5) ? cv : ck) + ((size_t)b * 2048 + 8) * 1024) + off; vv = __builtin_nontemporal_load(src); } }
#define CP_ST(vv, u) { const unsigned ix = i0 + (u) * NWAVES * 64u; if (ix < hi) { const unsigned zb = ix / SEG4, off = ix - zb * SEG4; const unsigned b = zb & 31u; \
            f32x4* dst = (f32x4*)(F.out + ((zb >> 5) ? O_VS : O_KS) + (size_t)b * 2048 * 1024) + off; __builtin_nontemporal_store(vv, dst); } }
        CP_LD(v0, 0u) CP_LD(v1, 1u) CP_LD(v2, 2u) CP_LD(v3, 3u)
        CP_ST(v0, 0u) CP_ST(v1, 1u) CP_ST(v2, 2u) CP_ST(v3, 3u)
#undef CP_LD
#undef CP_ST
    }
}

namespace smp {
__device__ __forceinline__ void unit(Frame& F, const Args& A, int b, int g) {
    const int t = F.wave, lane = F.lane;
    const int m = MP + b * 8 + t;
    const bf16* P = (const bf16*)(F.ws + WS_P);
    const float* TAB = (const float*)(F.ws + WS_TAB) + TAB_BT;
    float* SPO = (float*)(F.ws + WS_SPO); float* SPM = (float*)(F.ws + WS_SPM); float* SPL = SPM + 32 * 8 * 8 * 16;
    float q[4][4];
#pragma unroll
    for (int i = 0; i < 4; ++i) { const v2u qv = *(const v2u*)(P + (size_t)m * 1024 + 256 * i + 4 * lane); q[i][0] = bflo(qv.x); q[i][1] = bfhi(qv.x); q[i][2] = bflo(qv.y); q[i][3] = bfhi(qv.y); }
    float mr[4], l[4], o[4][4];
#pragma unroll
    for (int i = 0; i < 4; ++i) { mr[i] = -INFINITY; l[i] = 0.f; o[i][0] = o[i][1] = o[i][2] = o[i][3] = 0.f; }
    const int e0 = 49 * g, e1 = (e0 + 49 < 387) ? e0 + 49 : 387;
    const float* ck = A.in[2] + (size_t)b * 2048 * 1024; const float* cv = A.in[3] + (size_t)b * 2048 * 1024;
    const float* nk = F.out + O_KS + (size_t)b * 2048 * 1024; const float* nv = F.out + O_VS + (size_t)b * 2048 * 1024;
    for (int e = e0; e < e1; ++e) {
        const int p = e / 129, s = e - 129 * p;
        const int j = 2048 + t - (s << (2 * p));
        const float* kr = (j < 2048) ? ck + (size_t)j * 1024 : nk + (size_t)(j - 8) * 1024;
        const float* vr = (j < 2048) ? cv + (size_t)j * 1024 : nv + (size_t)(j - 8) * 1024;
        f32x4 k4[4], v4[4];
#pragma unroll
        for (int i = 0; i < 4; ++i) { k4[i] = *(const f32x4*)(kr + 256 * i + 4 * lane); v4[i] = *(const f32x4*)(vr + 256 * i + 4 * lane); }
#pragma unroll
        for (int i = 0; i < 4; ++i) {
            float d = k4[i][0] * q[i][0] + k4[i][1] * q[i][1] + k4[i][2] * q[i][2] + k4[i][3] * q[i][3];
            d += __shfl_xor(d, 1); d += __shfl_xor(d, 2); d += __shfl_xor(d, 4); d += __shfl_xor(d, 8);
            const int hd = 4 * i + (lane >> 4);
            const float s2 = d + TAB[hd * 396 + p * 132 + s];
            const float mn = fmaxf(mr[i], s2), al = ex2(mr[i] - mn), pp = ex2(s2 - mn);
            l[i] = l[i] * al + pp; mr[i] = mn;
#pragma unroll
            for (int k = 0; k < 4; ++k) o[i][k] = o[i][k] * al + pp * v4[i][k];
        }
    }
    const size_t pi = ((size_t)(b * 8 + g) * 8 + t);
#pragma unroll
    for (int i = 0; i < 4; ++i) {
        *(f32x4*)(SPO + pi * 1024 + 256 * i + 4 * lane) = (f32x4){o[i][0], o[i][1], o[i][2], o[i][3]};
        if ((lane & 15) == 0) { const int hd = 4 * i + (lane >> 4); SPM[pi * 16 + hd] = mr[i]; SPL[pi * 16 + hd] = l[i]; }
    }
    VM_WAIT(); __syncthreads();
    if (F.tid == 0) {
        __builtin_amdgcn_fence(__ATOMIC_RELEASE, "agent");
        asm volatile("s_waitcnt vmcnt(0)" ::: "memory");
        const unsigned old = __hip_atomic_fetch_add((unsigned*)(F.ctl + CW_SCNT + 64 * b), 1u, __ATOMIC_RELAXED, __HIP_MEMORY_SCOPE_AGENT);
        const unsigned last = (old == 7u) ? 1u : 0u;
        if (last) { __builtin_amdgcn_fence(__ATOMIC_ACQUIRE, "agent"); asm volatile("s_waitcnt vmcnt(0)" ::: "memory"); }
        F.MISC[16] = last;
    }
    __syncthreads();
    const bool last = F.MISC[16] != 0u;
    __syncthreads();
    if (!last) return;
    float M[4], L[4], O[4][4];
#pragma unroll
    for (int i = 0; i < 4; ++i) { M[i] = -INFINITY; L[i] = 0.f; O[i][0] = O[i][1] = O[i][2] = O[i][3] = 0.f; }
    for (int gg = 0; gg < 8; ++gg) { const size_t pj = ((size_t)(b * 8 + gg) * 8 + t);
#pragma unroll
        for (int i = 0; i < 4; ++i) M[i] = fmaxf(M[i], SPM[pj * 16 + 4 * i + (lane >> 4)]); }
    for (int gg = 0; gg < 8; ++gg) { const size_t pj = ((size_t)(b * 8 + gg) * 8 + t);
#pragma unroll
        for (int i = 0; i < 4; ++i) { const int hd = 4 * i + (lane >> 4); const float wgt = ex2(SPM[pj * 16 + hd] - M[i]); L[i] += SPL[pj * 16 + hd] * wgt;
            const f32x4 ov = *(const f32x4*)(SPO + pj * 1024 + 256 * i + 4 * lane);
#pragma unroll
            for (int k = 0; k < 4; ++k) O[i][k] += ov[k] * wgt; } }
    bf16* Y = (bf16*)(F.ws + WS_Y); float* SSQ = (float*)(F.ws + WS_SSQ);
#pragma unroll
    for (int i = 0; i < 4; ++i) {
        const float rl = 1.f / L[i]; float ov[4], ss = 0.f;
#pragma unroll
        for (int k = 0; k < 4; ++k) { ov[k] = O[i][k] * rl; ss += ov[k] * ov[k]; }
        ss += __shfl_xor(ss, 1); ss += __shfl_xor(ss, 2); ss += __shfl_xor(ss, 4); ss += __shfl_xor(ss, 8);
        const int col = 256 * i + 4 * lane;
        if ((lane & 15) == 0) SSQ[(size_t)m * 32 + 4 * i + (lane >> 4)] = ss;
        const v2u gv = *(const v2u*)(P + 3 * PREG + (size_t)m * 1024 + col);
        const f32x4 nw = *(const f32x4*)(A.in[9] + col);
        const float g0 = bflo(gv.x), g1 = bfhi(gv.x), g2 = bflo(gv.y), g3 = bfhi(gv.y);
        v2u yo; yo.x = pk2(ov[0] * siluf_(g0) * nw[0], ov[1] * siluf_(g1) * nw[1]); yo.y = pk2(ov[2] * siluf_(g2) * nw[2], ov[3] * siluf_(g3) * nw[3]);
        *(v2u*)(Y + (size_t)m * 2048 + col) = yo;
    }
}
}


__device__ __forceinline__ void final_norm(Frame& F, const Args& A) {
    const int gw = F.vcu * NWAVES + F.wave, NGW = F.G * NWAVES;
    const GAS f32x4* gf = (const GAS f32x4*)A.in[19] + F.lane;
    for (int m = gw; m < MT; m += NGW) {
        GAS f32x4* zr = (GAS f32x4*)(F.out + (size_t)m * DM) + F.lane;
        f32x4 v[4]; float s = 0.f;
#pragma unroll
        for (int j = 0; j < 4; ++j) { v[j] = zr[64 * j]; s += (v[j].x * v[j].x + v[j].y * v[j].y) + (v[j].z * v[j].z + v[j].w * v[j].w); }
        const float rstd = 1.f / sqrtf(wave_sum(s) * (1.f / DM) + EPS);
#pragma unroll
        for (int j = 0; j < 4; ++j) { const f32x4 g = gf[64 * j]; zr[64 * j] = (f32x4){v[j].x * rstd * g.x, v[j].y * rstd * g.y, v[j].z * rstd * g.z, v[j].w * rstd * g.w}; }
    }
}

__global__ void __launch_bounds__(NWAVES * 64, 2) fwd_kernel(Args args) {
    extern __shared__ __attribute__((aligned(16))) unsigned char lds[];
    Frame F;
    F.lds = (LAS unsigned char*)lds;
    F.MISC = (volatile LAS unsigned*)(F.lds + MISC_OFF);
    F.tid = threadIdx.x; F.lane = F.tid & 63; F.wave = __builtin_amdgcn_readfirstlane(F.tid >> 6);
    F.G = gridDim.x; { const int bx = blockIdx.x; F.vcu = (F.G % 8 == 0) ? (bx % 8) * (F.G / 8) + bx / 8 : bx; }
    F.out = args.out; F.ws = args.ws;
    F.ctl = (gu32*)(args.ws + WS_CTL);
    for (int u = F.tid; u < (LDS_BYTES - LDSCTL_OFF) / 4; u += NWAVES * 64) ((LAS unsigned*)(F.lds + LDSCTL_OFF))[u] = 0u;
    __syncthreads();
    XcdBarrier bar; bar.bar = (unsigned*)(F.ctl + CW_BAR); bar.x = 0; bar.st = nullptr;
    if (N_LAUNCHES != PER_PHASE) bar = xcd_barrier_post((unsigned*)(F.ctl + CW_BAR), F.MISC + 8);
#define GRID_BAR() do { if (N_LAUNCHES != PER_PHASE) xcd_barrier(bar); } while (0)
    const int lo = args.ph_lo, hi = args.ph_hi;
#ifndef PHASE_MASK
#define PHASE_MASK 0xff
#endif
#define IN(k) (((PHASE_MASK >> (k)) & 1) && lo <= (k) && (k) < hi)
#define BOTH(k) (IN(k) && IN((k) + 1))

    if (IN(0)) { p0_prologue(F, args); if (BOTH(0)) GRID_BAR(); }

    if (IN(1)) {
        pg8::Gemm g{(const pg8::bf16_t*)(F.ws + WS_XN), (const pg8::bf16_t*)(F.ws + WS_WIN), MT, NPROJ, DM};
        pg8::StaticOrder S; S.init(MT, NPROJ, F.G, (int)blockIdx.x);
        pg8::EpiProj E{(pg8::bf16_t*)(F.ws + WS_P), F.out};
        pg8::gemm_phase<pg8::EpiProj, pg8::StaticOrder, PG8_ALIGN, PG8_SP2>(F.lds + RING_OFF, g, S, E);
        if (BOTH(1)) GRID_BAR();
    }

    if (IN(2)) {
#ifndef P2_MASK
#define P2_MASK 15
#endif
        if (P2_MASK & 1) for (int u = F.vcu; u < 144; u += F.G) {
            if (u < 128) lru::lru_unit(F, args, u & 15, (u >> 4) * SEQ, SEQ, SEQ, false, u >> 4);
            else lru::lru_unit(F, args, u - 128, MP, MS, DECT, true, 0);
        }
        if (!(P2_MASK & 2)) {} else if (F.G == 256) {
            const int bh = F.vcu >> 1, par = F.vcu & 1;
            for (int i = 0; i < 4; ++i) { const int J = par ? ((i == 0) ? 1 : (i == 1) ? 6 : (i == 2) ? 3 : 4) : ((i == 0) ? 0 : (i == 1) ? 7 : (i == 2) ? 2 : 5);
                att::attn_unit(F, args, bh >> 4, bh & 15, J); }
        } else {
            for (int u = F.vcu; u < 1024; u += F.G) att::attn_unit(F, args, u >> 7, (u >> 3) & 15, u & 7);
        }
        if (P2_MASK & 4) for (int u = F.vcu; u < 256; u += F.G) smp::unit(F, args, u >> 3, u & 7);
        if (P2_MASK & 8) copy_phase(F, args);
        if (BOTH(2)) GRID_BAR();
    }

    if (IN(3)) {
        pg8::Gemm g{(const pg8::bf16_t*)(F.ws + WS_Y), (const pg8::bf16_t*)(F.ws + WS_WOUT), MT, DM, DMIX};
        pg8::StaticOrder S; S.init(MT, DM, F.G, (int)blockIdx.x);
        LAS float* rs = (LAS float*)(F.lds + RS_OFF);
        {
            const float* SSQ = (const float*)(F.ws + WS_SSQ);
            pg8::Unit uu;
            for (int i = 0; i < 2; ++i) if (S.next(i, uu)) {
                if (F.tid < 256) { const float* sp = SSQ + ((size_t)uu.pm * 256 + F.tid) * 32; float sa = 0.f, sl = 0.f;
#pragma unroll
                    for (int k = 0; k < 16; ++k) { sa += sp[k]; sl += sp[16 + k]; }
                    const float ra = 1.f / sqrtf(sa * (1.f / 1024.f) + EPS), rl = 1.f / sqrtf(sl * (1.f / 1024.f) + EPS);
                    rs[i * 512 + F.tid * 2] = ra / rl; rs[i * 512 + F.tid * 2 + 1] = rl; }
            }
        }
        __syncthreads();
        pg8::EpiOut E{args.in[0], args.in[1], F.out, (const PG8_LAS float*)rs};
        pg8::gemm_phase<pg8::EpiOut, pg8::StaticOrder, PG8_ALIGN, PG8_SP2>(F.lds + RING_OFF, g, S, E);
        if (BOTH(3)) GRID_BAR();
    }

    if (IN(4)) { final_norm(F, args); }
#undef IN
#undef BOTH
#undef GRID_BAR
}

extern "C" void kernel_launch(void* const* d_in, const int* in_sizes, int n_in, void* d_out, int out_size, void* d_ws, size_t ws_size, hipStream_t stream) {
    static int grid = 0;
    if (grid == 0) {
        if (n_in != 20 || ws_size < WS_END) { fprintf(stderr, "kernel_launch: unexpected n_in %d / ws %zu\n", n_in, ws_size); grid = -1; return; }
        int dev = 0, cus = 0, per_cu = 0;
        if (hipGetDevice(&dev) != hipSuccess || hipDeviceGetAttribute(&cus, hipDeviceAttributeMultiprocessorCount, dev) != hipSuccess) { grid = -1; return; }
        if (hipFuncSetAttribute((const void*)fwd_kernel, hipFuncAttributeMaxDynamicSharedMemorySize, LDS_BYTES) != hipSuccess) { fprintf(stderr, "kernel_launch: hipFuncSetAttribute failed\n"); grid = -1; return; }
        if (hipOccupancyMaxActiveBlocksPerMultiprocessor(&per_cu, (const void*)fwd_kernel, NWAVES * 64, LDS_BYTES) != hipSuccess || per_cu < 1)
            fprintf(stderr, "kernel_launch: note: occupancy query reports %d workgroups per CU\n", per_cu);
        (void)hipGetLastError();
        grid = cus;
    }
    if (grid < 0) return;
    if (N_LAUNCHES != PER_PHASE) { if (hipMemsetAsync((char*)d_ws + WS_CTL, 0, CTL_ZERO_BYTES, stream) != hipSuccess) return; }
    else { if (hipMemsetAsync((char*)d_ws + WS_CTL, 0, CTL_ZERO_BYTES, stream) != hipSuccess) return; }
    Args a{};
    for (int i = 0; i < 20; ++i) a.in[i] = (const float*)d_in[i];
    a.out = (float*)d_out; a.ws = (unsigned char*)d_ws;
    if (N_LAUNCHES == 1) {
        a.ph_lo = 0; a.ph_hi = PER_PHASE; a.li = 0;
        hipLaunchKernelGGL(fwd_kernel, dim3(grid), dim3(NWAVES * 64), LDS_BYTES, stream, a);
    } else {
        for (int li = 0; li < PER_PHASE; ++li) { a.ph_lo = li; a.ph_hi = li + 1; a.li = li;
            hipLaunchKernelGGL(fwd_kernel, dim3(grid), dim3(NWAVES * 64), LDS_BYTES, stream, a); }
    }
}
```

```cpp
#include <hip/hip_runtime.h>
#include <hip/hip_bf16.h>
#include <cstdio>
#include <cstdint>
#include <cmath>

#ifndef MK_N_LAUNCHES
#define MK_N_LAUNCHES 1
#endif

constexpr int DM = 1024, NBATCH = 8, SEQ = 2048, DECB = 32, DECT = 8, WBK = 2048, NHEAD = 16, HDIM = 64;
constexpr int MP = NBATCH * SEQ;
constexpr int MS = DECB * DECT;
constexpr int MT = MP + MS;
constexpr int NPROJ = 6144, DMIX = 2048;
constexpr float EPS = 1e-6f;
constexpr float LOG2E = 1.4426950408889634f;
constexpr float QSCALE = 0.125f * LOG2E;
constexpr size_t O_YP = 0, O_YS = 16777216, O_KP = 17039360, O_VP = 33816576, O_CP = 50593792, O_LP = 50618368,
                 O_KS = 50626560, O_VS = 117735424, O_CS = 184844288, O_LS = 184942592;
constexpr size_t MiB = 1u << 20;
constexpr size_t WS_CTL = 0, CTL_ZERO_BYTES = 1 * MiB;
constexpr size_t WS_WIN = 2 * MiB;
constexpr size_t WS_WOUT = 14 * MiB;
constexpr size_t WS_WG = 18 * MiB;
constexpr size_t WS_TAB = 19 * MiB;
constexpr size_t WS_XN = 32 * MiB;
constexpr size_t WS_P = 66 * MiB;
constexpr size_t WS_Y = 261 * MiB;
constexpr size_t WS_SSQ = 326 * MiB;
constexpr size_t WS_SPO = 330 * MiB;
constexpr size_t WS_SPM = 339 * MiB;
constexpr size_t WS_END = 341 * MiB;
constexpr size_t PREG = (size_t)MT * 1024;
constexpr int TAB_BT = 0, TAB_LA0 = 16 * 3 * 132;

namespace pg8 {
#define PG8_LAS __attribute__((address_space(3)))
typedef unsigned short bf16_t;
typedef short bf16x8 __attribute__((ext_vector_type(8)));
typedef float f32x4 __attribute__((ext_vector_type(4)));
typedef unsigned u32x4 __attribute__((ext_vector_type(4)));
constexpr int BM = 256, BK = 64, HALF = 128, HTB = HALF * BK * 2  , STAGE_BYTES = 8 * HTB, NXCD = 8, WGM = 8;

__host__ __device__ __forceinline__ int lds_byte(int r, int c) { const int st = (r >> 4) * 2 + (c >> 5), rr = r & 15, cc = c & 31, ob = rr * 64 + cc * 2; return st * 1024 + (ob ^ (((ob >> 9) & 1) << 5)); }
__host__ __device__ __forceinline__ void stage_rc(int b, int& R, int& C) { const int st = b / 1024, sb = b % 1024, swz = sb ^ (((sb >> 9) & 1) << 5); R = (st >> 1) * 16 + swz / 64; C = (st & 1) * 32 + (swz % 64) / 2; }
__host__ __device__ __forceinline__ int perm32(int rho) { const int n = rho >> 4, i = rho & 15; return 8 * (i >> 2) + 4 * n + (i & 3); }

struct Unit { int pm, pn; };
struct Gemm { const bf16_t* A; const bf16_t* Bt; int M, N, K; };

struct StaticOrder {
    int nM, nN, nwg, G, c;
    __host__ __device__ void init(int M, int N, int G_, int c_) { nM = M / BM; nN = N / BM; nwg = nM * nN; G = G_; c = c_; }
    __host__ __device__ bool next(int i, Unit& u) const {
        const long L = (long)i * G + c; if (L >= nwg) return false;
        int wgid = (int)L; { const int q = nwg / NXCD, r = nwg % NXCD, xcd = wgid % NXCD, off = wgid / NXCD; wgid = (xcd < r ? xcd * (q + 1) : r * (q + 1) + (xcd - r) * q) + off; }
        const int nig = WGM * nN, gid = wgid / nig, fm = gid * WGM, gsz = (nM - fm) < WGM ? (nM - fm) : WGM;
        u.pm = fm + ((wgid % nig) % gsz); u.pn = (wgid % nig) / gsz; return true;
    }
    __device__ __forceinline__ void a_ready(const Unit&) const {}
    __device__ __forceinline__ void done(const Unit&) const {}
};

__device__ __forceinline__ unsigned cvt_pk_bf16(float lo, float hi) { unsigned r; asm volatile("v_cvt_pk_bf16_f32 %0, %1, %2" : "=v"(r) : "v"(lo), "v"(hi)); return r; }

struct EpiProj {
    static constexpr bool PERM = true, AFTER_DRAIN = false, MID = false;
    bf16_t* P; float* out;
    __device__ __forceinline__ void mid(f32x4 (&)[2][2][4][2], int, int, int) const {}
    __device__ __forceinline__ void operator()(const f32x4 (&acc)[2][2][4][2], const Unit& u, int ui, int wr, int wc, int fr, int fq) const {
        const int t = u.pn >> 2;
        const int colr = (u.pn & 3) * BM + wc * 32 + 8 * fq;
        const float sc = (t == 0) ? QSCALE : 1.f;
        bf16_t* base = P + (size_t)t * PREG;
        const bool smp = (u.pm == (MP / BM));
        float* fo = nullptr;
        if (t == 1) fo = out + (smp ? O_KS : O_KP); else if (t == 2) fo = out + (smp ? O_VS : O_VP);
        const int row0 = u.pm * BM + wr * 64 + fr;
#pragma unroll
        for (int ai = 0; ai < 2; ++ai)
#pragma unroll
            for (int m = 0; m < 4; ++m) {
                const int row = row0 + ai * HALF + m * 16;
                bf16_t* rowp = base + (size_t)row * 1024 + colr;
                size_t frow = (size_t)row;
                if (smp) { const int sr = row - MP; frow = (size_t)(sr >> 3) * 2048 + 2040 + (sr & 7); }
#pragma unroll
                for (int bj = 0; bj < 2; ++bj) {
                    const f32x4 a0 = acc[ai][bj][m][0], a1 = acc[ai][bj][m][1];
                    u32x4 w; w.x = cvt_pk_bf16(a0[0] * sc, a0[1] * sc); w.y = cvt_pk_bf16(a0[2] * sc, a0[3] * sc); w.z = cvt_pk_bf16(a1[0] * sc, a1[1] * sc); w.w = cvt_pk_bf16(a1[2] * sc, a1[3] * sc);
                    *(u32x4*)(rowp + bj * HALF) = w;
                    if (fo) { float* fp = fo + frow * 1024 + colr + bj * HALF; *(f32x4*)fp = a0; *(f32x4*)(fp + 4) = a1; }
                }
            }
    }
};

struct EpiOut {
    static constexpr bool PERM = false, AFTER_DRAIN = false, MID = true;
    const float* xp; const float* xs; float* out; const PG8_LAS float* rs;
    __device__ __forceinline__ void mid(f32x4 (&acc)[2][2][4][2], int ui, int wr, int fr) const {
        const PG8_LAS float* t = rs + (ui & 1) * 512;
#pragma unroll
        for (int ai = 0; ai < 2; ++ai)
#pragma unroll
            for (int m = 0; m < 4; ++m) { const float f = t[(ai * HALF + wr * 64 + m * 16 + fr) * 2];
#pragma unroll
                for (int bj = 0; bj < 2; ++bj)
#pragma unroll
                    for (int n = 0; n < 2; ++n) acc[ai][bj][m][n] = acc[ai][bj][m][n] * f; }
    }
    __device__ __forceinline__ void operator()(const f32x4 (&acc)[2][2][4][2], const Unit& u, int ui, int wr, int wc, int fr, int fq) const {
        const PG8_LAS float* t = rs + (ui & 1) * 512;
        const bool smp = (u.pm == (MP / BM));
        const int col0 = u.pn * BM + wc * 32 + 4 * fq;
#pragma unroll
        for (int ai = 0; ai < 2; ++ai)
#pragma unroll
            for (int m = 0; m < 4; ++m) {
                const int rl = ai * HALF + wr * 64 + m * 16 + fr, row = u.pm * BM + rl;
                const float f = t[rl * 2 + 1];
                const float* xr = smp ? xs + (size_t)(row - MP) * 1024 : xp + (size_t)row * 1024;
                float* orow = out + (size_t)row * 1024;
#pragma unroll
                for (int bj = 0; bj < 2; ++bj)
#pragma unroll
                    for (int n = 0; n < 2; ++n) { const int c = col0 + bj * HALF + n * 16; const f32x4 xv = *(const f32x4*)(xr + c); *(f32x4*)(orow + c) = xv + acc[ai][bj][m][n] * f; }
            }
    }
};

template <class Epi, class Sched, bool ALIGN_EPI = false, bool SP2 = false>
__device__ __forceinline__ void gemm_phase(PG8_LAS unsigned char* lds, const Gemm g, const Sched& S, const Epi& E) {
    const int tid = threadIdx.x, wid = __builtin_amdgcn_readfirstlane(tid >> 6), lane = tid & 63, wr = wid >> 2, wc = wid & 3, fr = lane & 15, fq = lane >> 4;
    const int K = g.K, nt = K / BK;
    unsigned voffA[2], voffB[2];
#pragma unroll
    for (int i = 0; i < 2; ++i) { int R, C; stage_rc(tid * 16 + i * 8192, R, C); const int Rb = Epi::PERM ? ((R & ~31) + perm32(R & 31)) : R;
        voffA[i] = (unsigned)(R * K + C) * 2u; voffB[i] = (unsigned)(Rb * K + C) * 2u; }
    const size_t kstep = (size_t)(BK * 2);
    const size_t hstep = (size_t)HALF * K * 2;
    const size_t tstep = 2 * hstep;
    const unsigned ldsw = (unsigned)wid * 1024u;
    const int aoff = lds_byte(wr * 64 + fr, fq * 8), boff = lds_byte(wc * 32 + fr, fq * 8);
#define PG8_SA(b, h) (((b) * 2 + (h)) * HTB)
#define PG8_SB(b, h) ((4 + (b) * 2 + (h)) * HTB)
#define PG8_STAGE(bufoff, gbase, voff) do { _Pragma("unroll") for (int _i = 0; _i < 2; ++_i) \
        __builtin_amdgcn_global_load_lds((const unsigned*)((const char*)(gbase) + (voff)[_i]), (PG8_LAS unsigned*)(lds + (bufoff) + ldsw + _i * 8192), 16, 0, 0); } while (0)
#define PG8_LDA(dst, b, h) do { _Pragma("unroll") for (int m = 0; m < 4; ++m) _Pragma("unroll") for (int k = 0; k < 2; ++k) dst[m][k] = *(const PG8_LAS bf16x8*)(lds + PG8_SA(b, h) + aoff + m * 2048 + k * 1024); } while (0)
#define PG8_LDB(dst, b, h) do { _Pragma("unroll") for (int n = 0; n < 2; ++n) _Pragma("unroll") for (int k = 0; k < 2; ++k) dst[n][k] = *(const PG8_LAS bf16x8*)(lds + PG8_SB(b, h) + boff + n * 2048 + k * 1024); } while (0)
#define PG8_MMA(ai, bj, At, Bt) do { __builtin_amdgcn_s_setprio(1); _Pragma("unroll") for (int m = 0; m < 4; ++m) _Pragma("unroll") for (int n = 0; n < 2; ++n) _Pragma("unroll") for (int k = 0; k < 2; ++k) \
        acc[ai][bj][m][n] = __builtin_amdgcn_mfma_f32_16x16x32_bf16(Bt[n][k], At[m][k], acc[ai][bj][m][n], 0, 0, 0); __builtin_amdgcn_s_setprio(0); } while (0)
#define PG8_WAIT_V(n) asm volatile("s_waitcnt vmcnt(" #n ")" ::: "memory")
#define PG8_WAIT_L(n) asm volatile("s_waitcnt lgkmcnt(" #n ")" ::: "memory")
#define PG8_BAR __builtin_amdgcn_s_barrier()
#define PG8_SCHED __builtin_amdgcn_sched_barrier(0)
    Unit cur, nxt; int ui = 0;
    if (!S.next(0, cur)) return;
    f32x4 acc[2][2][4][2];
#pragma unroll
    for (int a = 0; a < 2; ++a)
#pragma unroll
        for (int b = 0; b < 2; ++b)
#pragma unroll
            for (int m = 0; m < 4; ++m)
#pragma unroll
                for (int n = 0; n < 2; ++n) acc[a][b][m][n] = (f32x4){0.f, 0.f, 0.f, 0.f};
    bf16x8 At[4][2], B0[2][2], B1[2][2];
    const char* cA = (const char*)g.A + (size_t)cur.pm * tstep; const char* cB = (const char*)g.Bt + (size_t)cur.pn * tstep;
    S.a_ready(cur);
    if constexpr (SP2) {
        PG8_STAGE(PG8_SB(0, 0), cB, voffB); PG8_STAGE(PG8_SB(0, 1), cB + hstep, voffB); PG8_STAGE(PG8_SA(0, 0), cA, voffA); PG8_STAGE(PG8_SA(0, 1), cA + hstep, voffA);
        if (wr == 1) PG8_BAR;
        PG8_WAIT_V(2); PG8_BAR;
        PG8_STAGE(PG8_SB(1, 0), cB + kstep, voffB); PG8_STAGE(PG8_SA(1, 0), cA + kstep, voffA); PG8_STAGE(PG8_SB(1, 1), cB + hstep + kstep, voffB);
        PG8_WAIT_V(6); PG8_BAR;
    } else {
        PG8_STAGE(PG8_SB(0, 0), cB, voffB); PG8_STAGE(PG8_SA(0, 0), cA, voffA); PG8_STAGE(PG8_SB(0, 1), cB + hstep, voffB); PG8_STAGE(PG8_SA(0, 1), cA + hstep, voffA);
        if (wr == 1) PG8_BAR;
        PG8_WAIT_V(4); PG8_BAR;
        PG8_STAGE(PG8_SB(1, 0), cB + kstep, voffB); PG8_STAGE(PG8_SA(1, 0), cA + kstep, voffA); PG8_STAGE(PG8_SB(1, 1), cB + hstep + kstep, voffB);
        PG8_WAIT_V(6); PG8_BAR;
    }
    for (;;) {
        const bool has_next = S.next(ui + 1, nxt);
        const char* nA = has_next ? (const char*)g.A + (size_t)nxt.pm * tstep : cA; const char* nB = has_next ? (const char*)g.Bt + (size_t)nxt.pn * tstep : cB;
        for (int t = 0; t < nt; t += 2) {
            if constexpr (Epi::MID) { if (t == (nt >> 1)) E.mid(acc, ui, wr, fr); }
            const bool last = (t == nt - 2);
            const char* a1 = cA + (size_t)(t + 1) * kstep;
            const char* a2 = last ? nA : cA + (size_t)(t + 2) * kstep; const char* b2 = last ? nB : cB + (size_t)(t + 2) * kstep;
            const char* a3 = a2 + kstep; const char* b3 = b2 + kstep;
            if (last && has_next) S.a_ready(nxt);
            if constexpr (SP2) {
            PG8_LDB(B0, 0, 0); PG8_LDB(B1, 0, 1); PG8_SCHED; PG8_LDA(At, 0, 0); PG8_STAGE(PG8_SA(1, 1), a1 + hstep, voffA);
            PG8_WAIT_V(8); PG8_WAIT_L(0); PG8_BAR; PG8_MMA(0, 0, At, B0); PG8_MMA(0, 1, At, B1); PG8_BAR; PG8_SCHED;
            PG8_LDA(At, 0, 1); PG8_STAGE(PG8_SB(0, 0), b2, voffB); PG8_STAGE(PG8_SB(0, 1), b2 + hstep, voffB); PG8_STAGE(PG8_SA(0, 0), a2, voffA);
            PG8_WAIT_V(8); PG8_WAIT_L(0); PG8_BAR; PG8_MMA(1, 0, At, B0); PG8_MMA(1, 1, At, B1); PG8_BAR; PG8_SCHED;
            PG8_LDB(B0, 1, 0); PG8_LDB(B1, 1, 1); PG8_SCHED; PG8_LDA(At, 1, 0); PG8_STAGE(PG8_SA(0, 1), a2 + hstep, voffA);
            PG8_WAIT_V(8); PG8_WAIT_L(0); PG8_BAR; PG8_MMA(0, 0, At, B0); PG8_MMA(0, 1, At, B1); PG8_BAR; PG8_SCHED;
            PG8_LDA(At, 1, 1); PG8_STAGE(PG8_SB(1, 0), b3, voffB); PG8_STAGE(PG8_SB(1, 1), b3 + hstep, voffB); PG8_STAGE(PG8_SA(1, 0), a3, voffA);
            PG8_WAIT_V(8); PG8_WAIT_L(0); PG8_BAR; PG8_MMA(1, 0, At, B0); PG8_MMA(1, 1, At, B1); PG8_BAR; PG8_SCHED;
            } else {
            PG8_LDB(B0, 0, 0); PG8_SCHED; PG8_LDA(At, 0, 0); PG8_STAGE(PG8_SA(1, 1), a1 + hstep, voffA);
            PG8_WAIT_L(8); PG8_BAR; PG8_WAIT_L(0); PG8_MMA(0, 0, At, B0); PG8_BAR; PG8_SCHED;
            PG8_LDB(B1, 0, 1); PG8_STAGE(PG8_SB(0, 0), b2, voffB);
            PG8_BAR; PG8_WAIT_L(0); PG8_MMA(0, 1, At, B1); PG8_BAR;
            PG8_LDA(At, 0, 1); PG8_STAGE(PG8_SA(0, 0), a2, voffA);
            PG8_BAR; PG8_WAIT_L(0); PG8_MMA(1, 0, At, B0); PG8_BAR; PG8_SCHED;
            PG8_STAGE(PG8_SB(0, 1), b2 + hstep, voffB);
            PG8_WAIT_V(6); PG8_BAR; PG8_MMA(1, 1, At, B1); PG8_BAR;
            PG8_LDB(B0, 1, 0); PG8_SCHED; PG8_LDA(At, 1, 0); PG8_STAGE(PG8_SA(0, 1), a2 + hstep, voffA);
            PG8_WAIT_L(8); PG8_BAR; PG8_WAIT_L(0); PG8_MMA(0, 0, At, B0); PG8_BAR; PG8_SCHED;
            PG8_LDB(B1, 1, 1); PG8_STAGE(PG8_SB(1, 0), b3, voffB);
            PG8_BAR; PG8_WAIT_L(0); PG8_MMA(0, 1, At, B1); PG8_BAR;
            PG8_LDA(At, 1, 1); PG8_STAGE(PG8_SA(1, 0), a3, voffA);
            PG8_BAR; PG8_WAIT_L(0); PG8_MMA(1, 0, At, B0); PG8_BAR; PG8_SCHED;
            PG8_STAGE(PG8_SB(1, 1), b3 + hstep, voffB);
            PG8_WAIT_V(6); PG8_BAR; PG8_MMA(1, 1, At, B1); PG8_BAR;
            }
        }
        if constexpr (ALIGN_EPI) { if (wr == 0) PG8_BAR; }
        if constexpr (!Epi::AFTER_DRAIN) { E(acc, cur, ui, wr, wc, fr, fq); S.done(cur); }
        if (!has_next) break;
#pragma unroll
        for (int a = 0; a < 2; ++a)
#pragma unroll
            for (int b = 0; b < 2; ++b)
#pragma unroll
                for (int m = 0; m < 4; ++m)
#pragma unroll
                    for (int n = 0; n < 2; ++n) acc[a][b][m][n] = (f32x4){0.f, 0.f, 0.f, 0.f};
        cur = nxt; cA = nA; cB = nB; ++ui;
        if constexpr (ALIGN_EPI) { if (wr == 1) PG8_BAR; }
    }
    PG8_WAIT_V(0);
    if constexpr (!ALIGN_EPI) { if (wr == 0) PG8_BAR; }
    PG8_BAR;
    if constexpr (Epi::AFTER_DRAIN) { E.fused(acc, cur, wr, wc, fr, fq, lds, wid, lane); S.done(cur); }
#undef PG8_SA
#undef PG8_SB
#undef PG8_STAGE
#undef PG8_LDA
#undef PG8_LDB
#undef PG8_MMA
#undef PG8_WAIT_V
#undef PG8_WAIT_L
#undef PG8_BAR
#undef PG8_SCHED
}
}

#ifndef PG8_SP2
#define PG8_SP2 true
#endif
#ifndef PG8_ALIGN
#define PG8_ALIGN true
#endif

constexpr int NWAVES = 8;
constexpr int N_LAUNCHES = MK_N_LAUNCHES;
constexpr int PER_PHASE = 5;
constexpr int CW_TMO = 0, CW_CODE = 1;
constexpr int CW_BAR = 4096;
constexpr int CW_QA = 8192;
constexpr int CW_SCNT = 16384;
constexpr int RING_OFF = 0, RING_BYTES = 131072;
constexpr int LDSCTL_OFF = RING_BYTES, MISC_OFF = LDSCTL_OFF + 320;
constexpr int RS_OFF = RING_BYTES + 1024;
constexpr int LDS_BYTES = 147456;

#define GAS __attribute__((address_space(1)))
#define LAS __attribute__((address_space(3)))
typedef unsigned short bf16;
typedef unsigned v4u __attribute__((ext_vector_type(4)));
typedef unsigned v2u __attribute__((ext_vector_type(2)));
typedef float f32x4 __attribute__((ext_vector_type(4)));
typedef float f32x16 __attribute__((ext_vector_type(16)));
typedef short bf16x8 __attribute__((ext_vector_type(8)));
typedef short s16x4 __attribute__((ext_vector_type(4)));
typedef GAS unsigned gu32;
typedef GAS unsigned long long gu64;
#define RLX_AGENT __ATOMIC_RELAXED, __HIP_MEMORY_SCOPE_AGENT
#define LDS_WAIT() asm volatile("s_waitcnt lgkmcnt(0)" ::: "memory")
#define VM_WAIT() asm volatile("s_waitcnt vmcnt(0)" ::: "memory")
__device__ __forceinline__ unsigned f2bf(float f) { unsigned u = __builtin_bit_cast(unsigned, f); return (u + 0x7fffu + ((u >> 16) & 1u)) >> 16; }
__device__ __forceinline__ unsigned pk2(float lo, float hi) { return f2bf(lo) | (f2bf(hi) << 16); }
__device__ __forceinline__ float bflo(unsigned w) { return __builtin_bit_cast(float, w << 16); }
__device__ __forceinline__ float bfhi(unsigned w) { return __builtin_bit_cast(float, w & 0xffff0000u); }
__device__ __forceinline__ float bf1(unsigned short h) { return __builtin_bit_cast(float, (unsigned)h << 16); }
__device__ __forceinline__ float ex2(float x) { return __builtin_amdgcn_exp2f(x); }
__device__ __forceinline__ float lg2(float x) { return __builtin_amdgcn_logf(x); }
__device__ __forceinline__ float rcpf_(float x) { return __builtin_amdgcn_rcpf(x); }
__device__ __forceinline__ float sigmoidf_(float x) { return rcpf_(1.f + ex2(-x * LOG2E)); }
__device__ __forceinline__ float siluf_(float x) { return x * sigmoidf_(x); }

#define XB_TMO      128
#define XB_XCNT(j)  (256  + 64 * (j))
#define XB_XSUB(j)  (1280 + 64 * (j))
#define XB_XGEN(j)  (2304 + 64 * (j))
#define XB_TOP      3328
#define XB_TOPGEN   3392
#define XCD_BAR_WORDS 3456
#define XB_SPIN_CAP (1u << 18)

__device__ __forceinline__ unsigned xb_ld(unsigned* p)              { return __hip_atomic_load(p, __ATOMIC_RELAXED, __HIP_MEMORY_SCOPE_AGENT); }
__device__ __forceinline__ unsigned xb_add(unsigned* p, unsigned v) { return __hip_atomic_fetch_add(p, v, __ATOMIC_RELAXED, __HIP_MEMORY_SCOPE_AGENT); }
__device__ __forceinline__ unsigned xb_xcc_id() { return (unsigned)__builtin_amdgcn_s_getreg((3 << 11) | 20) & 0xFu; }
#define XB_SPIN(cond, bar) do { unsigned _sp = 0; while (cond) { __builtin_amdgcn_s_sleep(1); \
    if ((++_sp & 255u) == 0u) { if (xb_ld(&(bar)[XB_TMO])) break; if (_sp > XB_SPIN_CAP) { atomicAdd(&(bar)[XB_TMO], 1u); break; } } } } while (0)

struct XcdBarrier {
    unsigned* bar; unsigned x;
    volatile LAS unsigned* st;
};

__device__ __forceinline__ XcdBarrier xcd_barrier_post(unsigned* bar, volatile LAS unsigned* st) {
    XcdBarrier b; b.bar = bar; b.x = xb_xcc_id(); b.st = st;
    if (threadIdx.x == 0) (void)xb_add(&bar[XB_XCNT(b.x)], 1u);
    return b;
}
__device__ __forceinline__ void xcd_barrier_complete(unsigned* bar, unsigned x, unsigned& nloc, unsigned& nx) {
    const unsigned G = gridDim.x * gridDim.y * gridDim.z;
    unsigned sum, cnt, mine, sp = 0u;
    for (;;) {
        sum = 0u; cnt = 0u; mine = 0u;
#pragma unroll
        for (unsigned j = 0; j < 16; ++j) { const unsigned c = xb_ld(&bar[XB_XCNT(j)]); sum += c; cnt += (c > 0u) ? 1u : 0u; mine = (j == x) ? c : mine; }
        if (sum == G) break;
        __builtin_amdgcn_s_sleep(1);
        if ((++sp & 255u) == 0u) { if (xb_ld(&bar[XB_TMO])) break; if (sp > XB_SPIN_CAP) { atomicAdd(&bar[XB_TMO], 1u); break; } }
    }
    nloc = mine > 0u ? mine : 1u; nx = cnt > 0u ? cnt : 1u;
}

__device__ __forceinline__ void xcd_barrier(const XcdBarrier& b) {
    asm volatile("s_waitcnt vmcnt(0)" ::: "memory");
    __syncthreads();
    if (threadIdx.x == 0) {
        unsigned* bar = b.bar;
        __builtin_amdgcn_s_waitcnt(0);
        unsigned nloc = b.st[0], nx = b.st[1];
        if (nloc == 0u) { xcd_barrier_complete(bar, b.x, nloc, nx); b.st[0] = nloc; b.st[1] = nx; }
        const unsigned old = xb_add(&bar[XB_XSUB(b.x)], 1u);
        const unsigned gen = old / nloc;
        if (old + 1u == (gen + 1u) * nloc) {
            __builtin_amdgcn_fence(__ATOMIC_RELEASE, "agent");
            asm volatile("s_waitcnt vmcnt(0)" ::: "memory");
            const unsigned og = xb_add(&bar[XB_TOP], 1u);
            const unsigned tg = og / nx;
            if (og + 1u == (tg + 1u) * nx) xb_add(&bar[XB_TOPGEN], 1u);
            else XB_SPIN(xb_ld(&bar[XB_TOPGEN]) == tg, bar);
            __builtin_amdgcn_fence(__ATOMIC_ACQUIRE, "agent");
            xb_add(&bar[XB_XGEN(b.x)], 1u);
            asm volatile("s_waitcnt vmcnt(0)" ::: "memory");
        } else {
            XB_SPIN(xb_ld(&bar[XB_XGEN(b.x)]) == gen, bar);
            __builtin_amdgcn_fence(__ATOMIC_ACQUIRE, "agent");
            asm volatile("s_waitcnt vmcnt(0)" ::: "memory");
        }
    }
    __syncthreads();
}

struct Args { const float* in[20]; float* out; unsigned char* ws; int ph_lo, ph_hi, li, pad; };
struct Frame {
    LAS unsigned char* lds;
    volatile LAS unsigned* MISC;
    gu32* ctl;
    int tid, lane, wave;
    int vcu, G;
    float* out;
    unsigned char* ws;
};
__device__ __forceinline__ float wave_sum(float v) {
#pragma unroll
    for (int o = 1; o < 64; o <<= 1) v += __shfl_xor(v, o);
    return v;
}

__device__ __forceinline__ void p0_transpose_item(const float* W, int K, int N, bf16* WT, LAS float* scr, int item, int lane) {
    const int nblk = N / 32, kb = item / nblk, nb = item % nblk, k0 = 64 * kb, n0 = 32 * nb;
#pragma unroll 8
    for (int i = 0; i < 32; ++i) { const int kk = 2 * i + (lane >> 5); scr[kk * 33 + (lane & 31)] = W[(size_t)(k0 + kk) * N + n0 + (lane & 31)]; }
    LDS_WAIT(); asm volatile("" ::: "memory");
    const int c = lane & 7;
#pragma unroll
    for (int j = 0; j < 4; ++j) { const int n = (lane >> 3) + 8 * j; const LAS float* s = scr + (8 * c) * 33 + n;
        v4u o; o.x = pk2(s[0 * 33], s[1 * 33]); o.y = pk2(s[2 * 33], s[3 * 33]); o.z = pk2(s[4 * 33], s[5 * 33]); o.w = pk2(s[6 * 33], s[7 * 33]);
        *(GAS v4u*)(WT + (size_t)(n0 + n) * K + k0 + 8 * c) = o; }
    LDS_WAIT(); asm volatile("" ::: "memory");
}
__device__ __forceinline__ int t5_bucket(int d) {
    if (d < 16) return d;
    int b = 15;
    const int thr[16] = {16, 22, 30, 40, 54, 73, 99, 134, 182, 246, 332, 450, 609, 825, 1117, 1513};
#pragma unroll
    for (int i = 0; i < 16; ++i) b += (d >= thr[i]) ? 1 : 0;
    return b;
}
__device__ __forceinline__ void p0_prologue(Frame& F, const Args& A) {
    LAS float* scr = (LAS float*)(F.lds + RING_OFF + F.wave * 16384);
    const int gw = F.vcu * NWAVES + F.wave, NGW = F.G * NWAVES;
    constexpr int I_IN = (DM / 64) * (NPROJ / 32), I_OUT = (DMIX / 64) * (DM / 32), I_G = 16 * 2;
    constexpr int NITEMS = I_IN + I_OUT + 2 * I_G;
    bf16* WIN = (bf16*)(F.ws + WS_WIN); bf16* WOUT = (bf16*)(F.ws + WS_WOUT); bf16* WG = (bf16*)(F.ws + WS_WG);
    for (int it = gw; it < NITEMS; it += NGW) {
        int r = it;
        if (r < I_IN) { p0_transpose_item(A.in[8], DM, NPROJ, WIN, scr, r, F.lane); continue; } r -= I_IN;
        if (r < I_OUT) { p0_transpose_item(A.in[18], DMIX, DM, WOUT, scr, r, F.lane); continue; } r -= I_OUT;
        if (r < I_G) { const int blk = r >> 1; p0_transpose_item(A.in[13] + blk * 4096, 64, 64, WG + (blk * 2 + 0) * 4096, scr, r & 1, F.lane); continue; } r -= I_G;
        { const int blk = r >> 1; p0_transpose_item(A.in[15] + blk * 4096, 64, 64, WG + (blk * 2 + 1) * 4096, scr, r & 1, F.lane); }
    }
    bf16* XN = (bf16*)(F.ws + WS_XN);
    const GAS f32x4* gin = (const GAS f32x4*)A.in[7] + F.lane;
    for (int m = gw; m < MT; m += NGW) {
        const float* xrow = (m < MP) ? A.in[0] + (size_t)m * DM : A.in[1] + (size_t)(m - MP) * DM;
        const GAS f32x4* xr = (const GAS f32x4*)xrow + F.lane;
        f32x4 v[4]; float s = 0.f;
#pragma unroll
        for (int j = 0; j < 4; ++j) { v[j] = xr[64 * j]; s += (v[j].x * v[j].x + v[j].y * v[j].y) + (v[j].z * v[j].z + v[j].w * v[j].w); }
        const float rstd = 1.f / sqrtf(wave_sum(s) * (1.f / DM) + EPS);
        GAS unsigned long long* o8 = (GAS unsigned long long*)(XN + (size_t)m * DM) + F.lane;
#pragma unroll
        for (int j = 0; j < 4; ++j) { const f32x4 g = gin[64 * j];
            o8[64 * j] = (unsigned long long)pk2(v[j].x * rstd * g.x, v[j].y * rstd * g.y) | ((unsigned long long)pk2(v[j].z * rstd * g.z, v[j].w * rstd * g.w) << 32); }
    }
    float* TAB = (float*)(F.ws + WS_TAB);
    const int gt = F.vcu * (NWAVES * 64) + F.tid, NGT = F.G * NWAVES * 64;
    for (int i = gt; i < 16 * 3 * 132; i += NGT) {
        const int h = i / 396, rem = i % 396, p = rem / 132, s = rem % 132;
        const int sc = s > 128 ? 128 : s;
        TAB[TAB_BT + i] = A.in[6][t5_bucket(sc << (2 * p)) * 16 + h] * LOG2E;
    }
    for (int i = gt; i < 1024; i += NGT) {
        const float x = -A.in[17][i];
        TAB[TAB_LA0 + i] = -8.f * (fmaxf(x, 0.f) + log1pf(expf(-fabsf(x))));
    }
}


namespace att {
constexpr int A_ACCO = 0;
constexpr int A_ACCL = 32768;
constexpr int A_BT = 33792;
constexpr int A_WS = 35840;
constexpr int A_KV = 40960;
constexpr int A_END = A_KV + 8 * 8192;
constexpr float THR = 8.0f;
__device__ __forceinline__ int crow(int r, int hi) { return (r & 3) + 8 * (r >> 2) + 4 * hi; }
typedef short v4i16_t __attribute__((ext_vector_type(4)));
__device__ __forceinline__ s16x4 vtr(const LAS unsigned char* p) { return __builtin_bit_cast(s16x4, __builtin_amdgcn_ds_read_tr16_b64_v4i16((LAS v4i16_t*)p)); }
typedef float f32x2_t __attribute__((ext_vector_type(2))); typedef __bf16 bf16x2_t __attribute__((ext_vector_type(2)));
__device__ __forceinline__ unsigned cvtpk(float lo, float hi) { f32x2_t v = {lo, hi}; bf16x2_t b = __builtin_convertvector(v, bf16x2_t); return __builtin_bit_cast(unsigned, b); }

struct Geo { int dil, im, hb, res; };
__device__ __forceinline__ int tok_of(const Geo& g, int p0, int i) { return g.dil * (p0 + (i & g.im)) + g.res + ((i >> 4) & g.hb); }

struct WaveState { f32x16 o0, o1; float m, l; };

constexpr unsigned SEG4 = 2040u * 256u, N4 = 64u * SEG4;
struct BgCopy { unsigned cur, end; int pend0, pend1; f32x4 a0, a1, b0, b1; };
__device__ __forceinline__ const f32x4* bg_src(const float* ck, const float* cv, unsigned ix) { const unsigned zb = ix / SEG4, off = ix - zb * SEG4; return (const f32x4*)(((zb >> 5) ? cv : ck) + ((size_t)(zb & 31u) * 2048 + 8) * 1024) + off; }
__device__ __forceinline__ f32x4* bg_dst(float* out, unsigned ix) { const unsigned zb = ix / SEG4, off = ix - zb * SEG4; return (f32x4*)(out + ((zb >> 5) ? O_VS : O_KS) + (size_t)(zb & 31u) * 2048 * 1024) + off; }
#define BG_STORE4(c, p, x0, x1) do { if ((p) < (c).end) __builtin_nontemporal_store(x0, bg_dst(out, (p))); if ((p) + 64u < (c).end) __builtin_nontemporal_store(x1, bg_dst(out, (p) + 64u)); } while (0)
#define BG_LOAD4(c, p, x0, x1) do { if ((p) < (c).end) x0 = __builtin_nontemporal_load(bg_src(ck, cv, (p))); if ((p) + 64u < (c).end) x1 = __builtin_nontemporal_load(bg_src(ck, cv, (p) + 64u)); } while (0)
template <int SET> __device__ __forceinline__ void bg_step(BgCopy& c, const float* ck, const float* cv, float* out, int lane) {
    if (SET == 0) {
        if (c.pend0) { const unsigned p = (unsigned)c.pend0 - 1u + (unsigned)lane; BG_STORE4(c, p, c.a0, c.a1); c.pend0 = 0; }
        if (c.cur < c.end) { const unsigned p = c.cur + (unsigned)lane; BG_LOAD4(c, p, c.a0, c.a1); c.pend0 = (int)(c.cur + 1u); c.cur += 128u; }
    } else {
        if (c.pend1) { const unsigned p = (unsigned)c.pend1 - 1u + (unsigned)lane; BG_STORE4(c, p, c.b0, c.b1); c.pend1 = 0; }
        if (c.cur < c.end) { const unsigned p = c.cur + (unsigned)lane; BG_LOAD4(c, p, c.b0, c.b1); c.pend1 = (int)(c.cur + 1u); c.cur += 128u; }
    }
}
__device__ __forceinline__ void bg_flush(BgCopy& c, float* out, int lane) {
    if (c.pend0) { const unsigned p = (unsigned)c.pend0 - 1u + (unsigned)lane; BG_STORE4(c, p, c.a0, c.a1); c.pend0 = 0; }
    if (c.pend1) { const unsigned p = (unsigned)c.pend1 - 1u + (unsigned)lane; BG_STORE4(c, p, c.b0, c.b1); c.pend1 = 0; }
}

struct TileRegs { bf16x8 k[4]; v4u v[4]; };
__device__ __forceinline__ void tile_issue(TileRegs& t, const bf16* Kh, const bf16* Vh, const Geo& g, int kp0, int lane) {
    const int r32 = lane & 31, hi = lane >> 5;
    { const bf16* kr = Kh + (size_t)tok_of(g, kp0, r32) * 1024 + 8 * hi;
#pragma unroll
      for (int ks = 0; ks < 4; ++ks) t.k[ks] = *(const bf16x8*)(kr + 16 * ks); }
#pragma unroll
    for (int i = 0; i < 4; ++i) {
        const int row = 8 * i + (lane >> 3), cp = lane & 7;
        const int cv = cp ^ (((row >> 1) & 1) << 2);
        t.v[i] = *(const v4u*)(Vh + (size_t)tok_of(g, kp0, row) * 1024 + cv * 8);
    }
}

__device__ __forceinline__ void tile_compute(WaveState& st, const LAS unsigned char* Qw, const TileRegs& t, const Geo& g, int sbase,
                                             LAS unsigned char* Vw, LAS float* wsf, const LAS float* bt, int lane) {
    const int r32 = lane & 31, hi = lane >> 5;
#pragma unroll
    for (int i = 0; i < 4; ++i) *(LAS v4u*)(Vw + i * 1024 + lane * 16) = t.v[i];
    f32x16 S = {0.f, 0.f, 0.f, 0.f, 0.f, 0.f, 0.f, 0.f, 0.f, 0.f, 0.f, 0.f, 0.f, 0.f, 0.f, 0.f};
#pragma unroll
    for (int ks = 0; ks < 4; ++ks) { const bf16x8 qf = *(const LAS bf16x8*)(Qw + ks * 1024 + lane * 16); S = __builtin_amdgcn_mfma_f32_32x32x16_bf16(t.k[ks], qf, S, 0, 0, 0); }
    {
        const int sq = sbase + (r32 & g.im);
        const int qh = (r32 >> 4) & g.hb;
#pragma unroll
        for (int r = 0; r < 16; ++r) {
            const int kk = crow(r, hi);
            const int s = sq - (kk & g.im);
            const bool valid = ((unsigned)s <= 128u) && ((((kk >> 4) & g.hb)) == qh);
            const int sc = s < 0 ? 0 : (s > 128 ? 128 : s);
            const float v = S[r] + bt[sc];
            S[r] = valid ? v : -INFINITY;
        }
    }
    float mx = S[0];
#pragma unroll
    for (int r = 1; r < 16; ++r) mx = fmaxf(mx, S[r]);
    mx = fmaxf(mx, __shfl_xor(mx, 32));
    if (__any(mx > st.m + THR)) {
        const float mn = fmaxf(st.m, mx);
        const float al = ex2(st.m - mn);
        st.l *= al; st.m = mn;
        if (hi == 0) wsf[r32] = al;
        LDS_WAIT();
#pragma unroll
        for (int r = 0; r < 16; ++r) { const float f = wsf[crow(r, hi)]; st.o0[r] *= f; st.o1[r] *= f; }
    }
    float ps = 0.f;
#pragma unroll
    for (int r = 0; r < 16; ++r) { S[r] = ex2(S[r] - st.m); ps += S[r]; }
    st.l += ps;
    const int g16 = lane >> 4, i16 = lane & 15, q4 = i16 >> 2, p4 = i16 & 3;
    const LAS unsigned char* vb = Vw + (4 * hi + q4) * 128 + (((2 * (g16 & 1)) + (p4 >> 1)) << 4) + 8 * (p4 & 1);
    const int xo = (q4 >> 1) * 64;
#pragma unroll
    for (int ks = 0; ks < 2; ++ks) {
        v4u pw; pw.x = cvtpk(S[8 * ks + 0], S[8 * ks + 1]); pw.y = cvtpk(S[8 * ks + 2], S[8 * ks + 3]); pw.z = cvtpk(S[8 * ks + 4], S[8 * ks + 5]); pw.w = cvtpk(S[8 * ks + 6], S[8 * ks + 7]);
        const bf16x8 pa = __builtin_bit_cast(bf16x8, pw);
        const s16x4 a0 = vtr(vb + ks * 2048 + (0 ^ xo)), a1 = vtr(vb + ks * 2048 + 1024 + (0 ^ xo));
        const s16x4 b0 = vtr(vb + ks * 2048 + (64 ^ xo)), b1 = vtr(vb + ks * 2048 + 1024 + (64 ^ xo));
        const bf16x8 v0 = (bf16x8){a0[0], a0[1], a0[2], a0[3], a1[0], a1[1], a1[2], a1[3]};
        const bf16x8 v1 = (bf16x8){b0[0], b0[1], b0[2], b0[3], b1[0], b1[1], b1[2], b1[3]};
        st.o0 = __builtin_amdgcn_mfma_f32_32x32x16_bf16(pa, v0, st.o0, 0, 0, 0);
        st.o1 = __builtin_amdgcn_mfma_f32_32x32x16_bf16(pa, v1, st.o1, 0, 0, 0);
    }
}

__device__ __forceinline__ void merge(LAS unsigned char* base, const WaveState& st, int tl, bool first, bool keep_l, int w, int lane) {
    const int r32 = lane & 31, hi = lane >> 5;
    LAS float* wsf = (LAS float*)(base + A_WS) + w * 128;
    LAS float* accL = (LAS float*)(base + A_ACCL);
    LAS unsigned short* accO = (LAS unsigned short*)(base + A_ACCO);
    const float lt = st.l + __shfl_xor(st.l, 32);
    const float lse = st.m + lg2(lt);
    const float rl = rcpf_(lt);
    float wA = 0.f, wB = rl, lnew = lse;
    if (!first) { const float la = accL[tl]; const float M = fmaxf(la, lse); const float ea = ex2(la - M), eb = ex2(lse - M); const float sm = ea + eb; lnew = M + lg2(sm); const float inv = rcpf_(sm); wA = ea * inv; wB = eb * inv * rl; }
    if (hi == 0) { wsf[r32] = wA; wsf[32 + r32] = wB; ((LAS int*)wsf)[64 + r32] = tl; if (keep_l) accL[tl] = lnew; }
    LDS_WAIT();
#pragma unroll
    for (int r = 0; r < 16; ++r) {
        const int q = crow(r, hi);
        const float a = wsf[q], b = wsf[32 + q]; const int tq = ((LAS int*)wsf)[64 + q];
        LAS unsigned short* p0 = accO + tq * 64 + r32;
        float n0 = b * st.o0[r], n1 = b * st.o1[r];
        if (!first) { n0 += a * bf1(p0[0]); n1 += a * bf1(p0[32]); }
        p0[0] = (unsigned short)f2bf(n0); p0[32] = (unsigned short)f2bf(n1);
    }
}

__device__ __forceinline__ void attn_unit(Frame& F, const Args& A, int b, int h, int J, BgCopy& bg) {
    LAS unsigned char* base = F.lds + RING_OFF;
    const int lane = F.lane, w = F.wave, r32 = lane & 31, hi = lane >> 5;
    const bf16* P = (const bf16*)(F.ws + WS_P);
    const size_t rowb = (size_t)b * SEQ;
    const bf16* Qh = P + 0 * PREG + rowb * 1024 + h * 64;
    const bf16* Kh = P + 1 * PREG + rowb * 1024 + h * 64;
    const bf16* Vh = P + 2 * PREG + rowb * 1024 + h * 64;
    { const float* TAB = (const float*)(F.ws + WS_TAB) + TAB_BT + h * 396; LAS float* bt = (LAS float*)(base + A_BT);
      if (F.tid < 396) bt[F.tid] = TAB[F.tid]; }
    __syncthreads();
    LAS unsigned char* Vw0 = base + A_KV + w * 8192;
    LAS unsigned char* Qw = Vw0 + 4096;
    const float* cck = A.in[2]; const float* ccv = A.in[3];
    LAS float* wsf = (LAS float*)(base + A_WS) + w * 128;
#pragma unroll 1
    for (int pat = 0; pat < 3; ++pat) {
        Geo g; int qp0, tl;
        if (pat == 0)      { g.dil = 16; g.im = 15; g.hb = 1; g.res = 2 * w;  qp0 = 16 * J;                 tl = 16 * (r32 & 15) + 2 * w + (r32 >> 4); }
        else if (pat == 1) { g.dil = 4;  g.im = 31; g.hb = 0; g.res = w & 3;  qp0 = 64 * J + 32 * (w >> 2); tl = 4 * (32 * (w >> 2) + r32) + (w & 3); }
        else               { g.dil = 1;  g.im = 31; g.hb = 0; g.res = 0;      qp0 = 256 * J + 32 * w;       tl = 32 * w + r32; }
        const LAS float* bt = (const LAS float*)(base + A_BT) + (2 - pat) * 132;
        { const bf16* qrow = Qh + (size_t)tok_of(g, qp0, r32) * 1024 + 8 * hi;
#pragma unroll
          for (int ks = 0; ks < 4; ++ks) { const bf16x8 qv = *(const bf16x8*)(qrow + 16 * ks); *(LAS bf16x8*)(Qw + ks * 1024 + lane * 16) = qv; } }
        WaveState st; st.m = -INFINITY; st.l = 0.f;
#pragma unroll
        for (int r = 0; r < 16; ++r) { st.o0[r] = 0.f; st.o1[r] = 0.f; }
        int kp, kend, kstep, sb;
        if (pat == 0) { kp = 0; kend = 16 * J; kstep = 16; sb = 16 * J; }
        else { kp = qp0 - 128; kend = qp0; kstep = 32; sb = 128; if (kp < 0) { sb += kp; kp = 0; } }
        TileRegs ta, tb;
        tile_issue(ta, Kh, Vh, g, kp, lane);
#pragma unroll 1
        for (;;) {
            bool more = (kp + kstep <= kend);
            if (more) tile_issue(tb, Kh, Vh, g, kp + kstep, lane);
            bg_step<0>(bg, cck, ccv, F.out, lane);
            tile_compute(st, Qw, ta, g, sb, Vw0, wsf, bt, lane);
            if (!more) break;
            kp += kstep; sb -= kstep;
            more = (kp + kstep <= kend);
            if (more) tile_issue(ta, Kh, Vh, g, kp + kstep, lane);
            bg_step<1>(bg, cck, ccv, F.out, lane);
            tile_compute(st, Qw, tb, g, sb, Vw0, wsf, bt, lane);
            if (!more) break;
            kp += kstep; sb -= kstep;
        }
        merge(base, st, tl, pat == 0, pat < 2, w, lane);
        if (pat < 2) __syncthreads();
    }
    LDS_WAIT(); asm volatile("" ::: "memory");
    const int c8 = lane & 7;
    const LAS unsigned char* accO = base + A_ACCO;
    const bf16* GA = P + 3 * PREG; bf16* Y = (bf16*)(F.ws + WS_Y); float* SSQ = (float*)(F.ws + WS_SSQ);
    const float* nw = A.in[9] + h * 64 + 8 * c8;
    const f32x4 nw0 = *(const f32x4*)nw, nw1 = *(const f32x4*)(nw + 4);
#pragma unroll
    for (int i = 0; i < 4; ++i) {
        const int tloc = 32 * w + 8 * i + (lane >> 3);
        const size_t m = rowb + 256 * J + tloc;
        const v4u ov = *(const LAS v4u*)(accO + tloc * 128 + c8 * 16);
        const v4u gv = *(const v4u*)(GA + m * 1024 + h * 64 + 8 * c8);
        float o[8] = {bflo(ov.x), bfhi(ov.x), bflo(ov.y), bfhi(ov.y), bflo(ov.z), bfhi(ov.z), bflo(ov.w), bfhi(ov.w)};
        float gg[8] = {bflo(gv.x), bfhi(gv.x), bflo(gv.y), bfhi(gv.y), bflo(gv.z), bfhi(gv.z), bflo(gv.w), bfhi(gv.w)};
        float ss = 0.f;
#pragma unroll
        for (int k = 0; k < 8; ++k) ss += o[k] * o[k];
        ss += __shfl_xor(ss, 1); ss += __shfl_xor(ss, 2); ss += __shfl_xor(ss, 4);
        if (c8 == 0) SSQ[m * 32 + h] = ss;
        float y[8];
#pragma unroll
        for (int k = 0; k < 8; ++k) y[k] = o[k] * siluf_(gg[k]) * (k < 4 ? nw0[k] : nw1[k - 4]);
        v4u yo; yo.x = pk2(y[0], y[1]); yo.y = pk2(y[2], y[3]); yo.z = pk2(y[4], y[5]); yo.w = pk2(y[6], y[7]);
        *(v4u*)(Y + m * 2048 + h * 64 + 8 * c8) = yo;
    }
    __syncthreads();
}
}


namespace lru {
constexpr int TC = 64;
constexpr int L_XCS = 0;
constexpr int L_AB = 16384;
constexpr int L_HS = 81920;
constexpr int L_CW = 114688;
typedef float f32x2_t __attribute__((ext_vector_type(2)));
__device__ __forceinline__ void unpack8(const v4u a, float (&x)[8]) { x[0] = bflo(a.x); x[1] = bfhi(a.x); x[2] = bflo(a.y); x[3] = bfhi(a.y); x[4] = bflo(a.z); x[5] = bfhi(a.z); x[6] = bflo(a.w); x[7] = bfhi(a.w); }

__device__ __forceinline__ void lru_unit(Frame& F, const Args& A, int cb, int R0, int nrows, int TSEG, bool smp, int bidx0) {
    LAS unsigned char* base = F.lds + RING_OFF;
    const int tid = F.tid, w = F.wave;
    const bf16* P = (const bf16*)(F.ws + WS_P);
    const bf16* XR = P + 4 * PREG + cb * 64; const bf16* GR = P + 5 * PREG + cb * 64;
    bf16* Y = (bf16*)(F.ws + WS_Y) + 1024 + cb * 64; float* SSQ = (float*)(F.ws + WS_SSQ);
    const float* TAB = (const float*)(F.ws + WS_TAB);
    const int ch0 = cb * 64;
    const int nchunk = nrows / TC;
    { LAS float* cl = (LAS float*)(base + L_CW); if (tid < 384) { const int k = tid >> 6, c = tid & 63; cl[tid] = (k < 4) ? A.in[11][k * 1024 + ch0 + c] : (k == 4 ? A.in[12][ch0 + c] : A.in[10][ch0 + c]); } }
    __syncthreads();
#define LRU_BAR() do { asm volatile("s_waitcnt lgkmcnt(0)" ::: "memory"); __builtin_amdgcn_s_barrier(); asm volatile("" ::: "memory"); } while (0)
#define LRU_GLOAD(co, rbase) do { _Pragma("unroll") for (int k = 0; k < 4; ++k) gl[k] = *(const v4u*)(GR + ((size_t)R0 + (co) * TC + (rbase) + (lane >> 3) + 8 * k) * 1024 + c8); } while (0)
#define LRU_OUT(co, rbase) do { const LAS float* hs = (const LAS float*)(base + L_HS + ((co) & 1) * 16384); \
        _Pragma("unroll") for (int k = 0; k < 4; ++k) { const int row = (rbase) + (lane >> 3) + 8 * k; const size_t m = (size_t)R0 + (co) * TC + row; \
            const f32x4 h0 = *(const LAS f32x4*)(hs + row * 64 + c8), h1 = *(const LAS f32x4*)(hs + row * 64 + c8 + 4); \
            float g[8]; unpack8(gl[k], g); const float hv[8] = {h0[0], h0[1], h0[2], h0[3], h1[0], h1[1], h1[2], h1[3]}; float y[8], ss = 0.f; \
            _Pragma("unroll") for (int j = 0; j < 8; ++j) { ss += hv[j] * hv[j]; y[j] = hv[j] * siluf_(g[j]) * cwl[320 + j]; } \
            ss += __shfl_xor(ss, 1); ss += __shfl_xor(ss, 2); ss += __shfl_xor(ss, 4); \
            if ((lane & 7) == 0) SSQ[m * 32 + 16 + cb] = ss; \
            v4u y0; y0.x = pk2(y[0], y[1]); y0.y = pk2(y[2], y[3]); y0.z = pk2(y[4], y[5]); y0.w = pk2(y[6], y[7]); \
            *(v4u*)(Y + m * 2048 + c8) = y0; } } while (0)
    if (w == 0) {
      int ln = F.lane; asm volatile("" : "+v"(ln));
      const int lane = ln, c8 = 8 * (lane & 7);
      const LAS float* cwl = (const LAS float*)(base + L_CW) + c8;
      v4u gl[4];
      LRU_GLOAD(0, 32);
      float hcar = 0.f;
      for (int i = -2; i <= nchunk; ++i) {
        if (i >= 0 && i < nchunk) {
            const LAS f32x2_t* ab = (const LAS f32x2_t*)(base + L_AB + (i & 1) * 32768);
            LAS float* hs = (LAS float*)(base + L_HS + (i & 1) * 16384);
            if (!smp) {
#pragma unroll 16
                for (int r = 0; r < TC; ++r) { const f32x2_t v = ab[r * 64 + lane]; hcar = v.x * hcar + v.y; hs[r * 64 + lane] = hcar; }
                if (i == nchunk - 1) F.out[O_LP + (size_t)bidx0 * 1024 + ch0 + lane] = hcar;
            } else {
                float hnext = A.in[5][(size_t)(i * 8) * 1024 + ch0 + lane];
#pragma unroll 1
                for (int sg = 0; sg < 8; ++sg) {
                    hcar = hnext;
                    if (sg < 7) hnext = A.in[5][(size_t)(i * 8 + sg + 1) * 1024 + ch0 + lane];
#pragma unroll
                    for (int r8 = 0; r8 < 8; ++r8) { const int r = sg * 8 + r8; const f32x2_t v = ab[r * 64 + lane]; hcar = v.x * hcar + v.y; hs[r * 64 + lane] = hcar; }
                    F.out[O_LS + (size_t)(i * 8 + sg) * 1024 + ch0 + lane] = hcar;
                }
            }
        }
        const int co = i - 1;
        if (co >= 0 && co < nchunk) { LRU_OUT(co, 32); if (co + 1 < nchunk) LRU_GLOAD(co + 1, 32); }
        LRU_BAR();
      }
    } else if (w <= 4) {
      int ln = F.lane; asm volatile("" : "+v"(ln));
      const int lane = ln;
      bf16x8 wb[2][4][2]; float bgx[4], bga[4], la0[4];
      { const bf16* WG = (const bf16*)(F.ws + WS_WG) + (size_t)cb * 2 * 4096;
#pragma unroll
        for (int g = 0; g < 2; ++g)
#pragma unroll
            for (int n = 0; n < 4; ++n)
#pragma unroll
                for (int ks = 0; ks < 2; ++ks) wb[g][n][ks] = *(const bf16x8*)(WG + g * 4096 + (16 * n + (lane & 15)) * 64 + 32 * ks + 8 * (lane >> 4));
#pragma unroll
        for (int n = 0; n < 4; ++n) { const int cg = ch0 + 16 * n + (lane & 15); bgx[n] = A.in[14][cg]; bga[n] = A.in[16][cg]; la0[n] = TAB[TAB_LA0 + cg] * LOG2E; } }
      for (int i = -2; i <= nchunk; ++i) {
        const int c = i + 1;
        if (c >= 0 && c < nchunk) {
            const LAS unsigned char* xs = base + L_XCS + (c & 1) * 8192;
            LAS f32x2_t* ab = (LAS f32x2_t*)(base + L_AB + (c & 1) * 32768);
            const int arow = 16 * (w - 1) + (lane & 15), g4 = lane >> 4, sw = (arow >> 1) & 7;
            bf16x8 af[2];
#pragma unroll
            for (int ks = 0; ks < 2; ++ks) af[ks] = *(const LAS bf16x8*)(xs + arow * 128 + (((4 * ks + g4) ^ sw) << 4));
#pragma unroll
            for (int n = 0; n < 4; ++n) {
                f32x4 ax = {0.f, 0.f, 0.f, 0.f}, aa = {0.f, 0.f, 0.f, 0.f};
#pragma unroll
                for (int ks = 0; ks < 2; ++ks) { ax = __builtin_amdgcn_mfma_f32_16x16x32_bf16(af[ks], wb[0][n][ks], ax, 0, 0, 0); aa = __builtin_amdgcn_mfma_f32_16x16x32_bf16(af[ks], wb[1][n][ks], aa, 0, 0, 0); }
                const int cl = 16 * n + (lane & 15);
#pragma unroll
                for (int rg = 0; rg < 4; ++rg) {
                    const int row = 16 * (w - 1) + 4 * g4 + rg;
                    const float xc = bf1(*(const LAS unsigned short*)(xs + row * 128 + ((((cl >> 3) ^ ((row >> 1) & 7))) << 4) + (cl & 7) * 2));
                    const float gx = sigmoidf_(ax[rg] + bgx[n]), ga = sigmoidf_(aa[rg] + bga[n]);
                    const float a = ex2(ga * la0[n]);
                    const float mult = sqrtf(fmaxf(1.f - a * a, 0.f));
                    ab[row * 64 + cl] = (f32x2_t){a, mult * gx * xc};
                }
            }
        }
        LRU_BAR();
      }
    } else if (w <= 6) {
      int t6 = tid - 320; asm volatile("" : "+v"(t6));
      const int q4 = t6 >> 3, c8 = 8 * (t6 & 7);
      const LAS float* cwl = (const LAS float*)(base + L_CW) + c8;
      v4u xl[7];
#define LRU_XLOAD(cc) do { _Pragma("unroll") for (int k = 0; k < 7; ++k) { int rs = (cc) * TC + 4 * q4 - 3 + k; rs = rs < 0 ? 0 : rs; xl[k] = *(const v4u*)(XR + ((size_t)R0 + rs) * 1024 + c8); } } while (0)
      LRU_XLOAD(0);
      for (int i = -2; i <= nchunk; ++i) {
        const int cc = i + 2;
        if (cc < nchunk) {
            LAS unsigned char* xs = base + L_XCS + (cc & 1) * 8192;
            const int rr0 = cc * TC + 4 * q4;
            float xv[7][8];
#pragma unroll
            for (int k = 0; k < 7; ++k) unpack8(xl[k], xv[k]);
            if (cc + 1 < nchunk) LRU_XLOAD(cc + 1);
            if (!smp) { if (rr0 == 0) {
#pragma unroll
                    for (int k = 0; k < 3; ++k)
#pragma unroll
                        for (int j = 0; j < 8; ++j) xv[k][j] = 0.f; } }
            else if ((rr0 & 4) == 0) {
                const float* cp = A.in[4] + (size_t)(rr0 >> 3) * 3 * 1024 + ch0 + c8;
#pragma unroll
                for (int k = 0; k < 3; ++k) { const f32x4 c0 = *(const f32x4*)(cp + k * 1024), c1 = *(const f32x4*)(cp + k * 1024 + 4);
                    xv[k][0] = c0[0]; xv[k][1] = c0[1]; xv[k][2] = c0[2]; xv[k][3] = c0[3]; xv[k][4] = c1[0]; xv[k][5] = c1[1]; xv[k][6] = c1[2]; xv[k][7] = c1[3]; }
            }
#pragma unroll
            for (int r = 0; r < 4; ++r) {
                const int row = 4 * q4 + r, rr = rr0 + r;
                float xc[8];
#pragma unroll
                for (int j = 0; j < 8; ++j) xc[j] = cwl[256 + j] + cwl[j] * xv[r][j] + cwl[64 + j] * xv[r + 1][j] + cwl[128 + j] * xv[r + 2][j] + cwl[192 + j] * xv[r + 3][j];
                const int tin = smp ? (rr & 7) : rr;
                if (tin >= TSEG - 3) { float* co = F.out + (smp ? O_CS : O_CP) + ((size_t)(smp ? (rr >> 3) : bidx0) * 3 + (tin - (TSEG - 3))) * 1024 + ch0 + c8;
                    *(f32x4*)(co) = (f32x4){xv[r + 3][0], xv[r + 3][1], xv[r + 3][2], xv[r + 3][3]}; *(f32x4*)(co + 4) = (f32x4){xv[r + 3][4], xv[r + 3][5], xv[r + 3][6], xv[r + 3][7]}; }
                v4u s0; s0.x = pk2(xc[0], xc[1]); s0.y = pk2(xc[2], xc[3]); s0.z = pk2(xc[4], xc[5]); s0.w = pk2(xc[6], xc[7]);
                *(LAS v4u*)(xs + row * 128 + ((((t6 & 7)) ^ ((row >> 1) & 7)) << 4)) = s0;
            }
        }
        LRU_BAR();
      }
#undef LRU_XLOAD
    } else {
      int ln = F.lane; asm volatile("" : "+v"(ln));
      const int lane = ln, c8 = 8 * (lane & 7);
      const LAS float* cwl = (const LAS float*)(base + L_CW) + c8;
      v4u gl[4];
      LRU_GLOAD(0, 0);
      for (int i = -2; i <= nchunk; ++i) {
        const int co = i - 1;
        if (co >= 0 && co < nchunk) { LRU_OUT(co, 0); if (co + 1 < nchunk) LRU_GLOAD(co + 1, 0); }
        LRU_BAR();
      }
    }
#undef LRU_GLOAD
#undef LRU_OUT
#undef LRU_BAR
}
}

__device__ __forceinline__ void copy_phase(Frame& F, const Args& A, att::BgCopy& bg) {
    const float* ck = A.in[2]; const float* cv = A.in[3];
    const int lane = F.lane;
    att::bg_flush(bg, F.out, lane);
    for (unsigned i0 = bg.cur + (unsigned)lane; i0 < bg.end; i0 += 512u) {
        f32x4 v[8];
#pragma unroll
        for (int u = 0; u < 8; ++u) { const unsigned ix = i0 + 64u * u; if (ix < bg.end) v[u] = __builtin_nontemporal_load(att::bg_src(ck, cv, ix)); }
#pragma unroll
        for (int u = 0; u < 8; ++u) { const unsigned ix = i0 + 64u * u; if (ix < bg.end) __builtin_nontemporal_store(v[u], att::bg_dst(F.out, ix)); }
    }
    bg.cur = bg.end;
}

namespace smp {
__device__ __forceinline__ void unit(Frame& F, const Args& A, int b, int g) {
    const int t = F.wave, lane = F.lane;
    const int m = MP + b * 8 + t;
    const bf16* P = (const bf16*)(F.ws + WS_P);
    const float* TAB = (const float*)(F.ws + WS_TAB) + TAB_BT;
    float* SPO = (float*)(F.ws + WS_SPO); float* SPM = (float*)(F.ws + WS_SPM); float* SPL = SPM + 32 * 8 * 8 * 16;
    float q[4][4];
#pragma unroll
    for (int i = 0; i < 4; ++i) { const v2u qv = *(const v2u*)(P + (size_t)m * 1024 + 256 * i + 4 * lane); q[i][0] = bflo(qv.x); q[i][1] = bfhi(qv.x); q[i][2] = bflo(qv.y); q[i][3] = bfhi(qv.y); }
    float mr[4], l[4], o[4][4];
#pragma unroll
    for (int i = 0; i < 4; ++i) { mr[i] = -INFINITY; l[i] = 0.f; o[i][0] = o[i][1] = o[i][2] = o[i][3] = 0.f; }
    const int e0 = 49 * g, e1 = (e0 + 49 < 387) ? e0 + 49 : 387;
    const float* ck = A.in[2] + (size_t)b * 2048 * 1024; const float* cv = A.in[3] + (size_t)b * 2048 * 1024;
    const float* nk = F.out + O_KS + (size_t)b * 2048 * 1024; const float* nv = F.out + O_VS + (size_t)b * 2048 * 1024;
#define SMP_ROWPTR(e_, kr_, vr_) const int p_##kr_ = (e_) / 129, s_##kr_ = (e_) - 129 * p_##kr_; const int j_##kr_ = 2048 + t - (s_##kr_ << (2 * p_##kr_)); \
        const float* kr_ = (j_##kr_ < 2048) ? ck + (size_t)j_##kr_ * 1024 : nk + (size_t)(j_##kr_ - 8) * 1024; \
        const float* vr_ = (j_##kr_ < 2048) ? cv + (size_t)j_##kr_ * 1024 : nv + (size_t)(j_##kr_ - 8) * 1024;
#define SMP_LOAD(K4, V4, e_) do { SMP_ROWPTR(e_, kr, vr) _Pragma("unroll") for (int i = 0; i < 4; ++i) { K4[i] = *(const f32x4*)(kr + 256 * i + 4 * lane); V4[i] = *(const f32x4*)(vr + 256 * i + 4 * lane); } } while (0)
#define SMP_PROC(K4, V4, e_) do { const int p = (e_) / 129, s = (e_) - 129 * p; \
        _Pragma("unroll") for (int i = 0; i < 4; ++i) { \
            float d = K4[i][0] * q[i][0] + K4[i][1] * q[i][1] + K4[i][2] * q[i][2] + K4[i][3] * q[i][3]; \
            d += __shfl_xor(d, 1); d += __shfl_xor(d, 2); d += __shfl_xor(d, 4); d += __shfl_xor(d, 8); \
            const int hd = 4 * i + (lane >> 4); \
            const float s2 = d + TAB[hd * 396 + p * 132 + s]; \
            const float mn = fmaxf(mr[i], s2), al = ex2(mr[i] - mn), pp = ex2(s2 - mn); \
            l[i] = l[i] * al + pp; mr[i] = mn; \
            _Pragma("unroll") for (int k = 0; k < 4; ++k) o[i][k] = o[i][k] * al + pp * V4[i][k]; } } while (0)
    {
        f32x4 ka[4], va[4], kb[4], vb[4];
        SMP_LOAD(ka, va, e0);
#pragma unroll 1
        for (int e = e0; e < e1; e += 2) {
            if (e + 1 < e1) SMP_LOAD(kb, vb, e + 1);
            SMP_PROC(ka, va, e);
            if (e + 2 < e1) SMP_LOAD(ka, va, e + 2);
            if (e + 1 < e1) SMP_PROC(kb, vb, e + 1);
        }
    }
#undef SMP_ROWPTR
#undef SMP_LOAD
#undef SMP_PROC
    const size_t pi = ((size_t)(b * 8 + g) * 8 + t);
#pragma unroll
    for (int i = 0; i < 4; ++i) {
        *(f32x4*)(SPO + pi * 1024 + 256 * i + 4 * lane) = (f32x4){o[i][0], o[i][1], o[i][2], o[i][3]};
        if ((lane & 15) == 0) { const int hd = 4 * i + (lane >> 4); SPM[pi * 16 + hd] = mr[i]; SPL[pi * 16 + hd] = l[i]; }
    }
    VM_WAIT(); __syncthreads();
    if (F.tid == 0) {
        __builtin_amdgcn_fence(__ATOMIC_RELEASE, "agent");
        asm volatile("s_waitcnt vmcnt(0)" ::: "memory");
        const unsigned old = __hip_atomic_fetch_add((unsigned*)(F.ctl + CW_SCNT + 64 * b), 1u, __ATOMIC_RELAXED, __HIP_MEMORY_SCOPE_AGENT);
        const unsigned last = (old == 7u) ? 1u : 0u;
        if (last) { __builtin_amdgcn_fence(__ATOMIC_ACQUIRE, "agent"); asm volatile("s_waitcnt vmcnt(0)" ::: "memory"); }
        F.MISC[16] = last;
    }
    __syncthreads();
    const bool last = F.MISC[16] != 0u;
    __syncthreads();
    if (!last) return;
    float M[4], L[4], O[4][4];
#pragma unroll
    for (int i = 0; i < 4; ++i) { M[i] = -INFINITY; L[i] = 0.f; O[i][0] = O[i][1] = O[i][2] = O[i][3] = 0.f; }
    for (int gg = 0; gg < 8; ++gg) { const size_t pj = ((size_t)(b * 8 + gg) * 8 + t);
#pragma unroll
        for (int i = 0; i < 4; ++i) M[i] = fmaxf(M[i], SPM[pj * 16 + 4 * i + (lane >> 4)]); }
    for (int gg = 0; gg < 8; ++gg) { const size_t pj = ((size_t)(b * 8 + gg) * 8 + t);
#pragma unroll
        for (int i = 0; i < 4; ++i) { const int hd = 4 * i + (lane >> 4); const float wgt = ex2(SPM[pj * 16 + hd] - M[i]); L[i] += SPL[pj * 16 + hd] * wgt;
            const f32x4 ov = *(const f32x4*)(SPO + pj * 1024 + 256 * i + 4 * lane);
#pragma unroll
            for (int k = 0; k < 4; ++k) O[i][k] += ov[k] * wgt; } }
    bf16* Y = (bf16*)(F.ws + WS_Y); float* SSQ = (float*)(F.ws + WS_SSQ);
#pragma unroll
    for (int i = 0; i < 4; ++i) {
        const float rl = 1.f / L[i]; float ov[4], ss = 0.f;
#pragma unroll
        for (int k = 0; k < 4; ++k) { ov[k] = O[i][k] * rl; ss += ov[k] * ov[k]; }
        ss += __shfl_xor(ss, 1); ss += __shfl_xor(ss, 2); ss += __shfl_xor(ss, 4); ss += __shfl_xor(ss, 8);
        const int col = 256 * i + 4 * lane;
        if ((lane & 15) == 0) SSQ[(size_t)m * 32 + 4 * i + (lane >> 4)] = ss;
        const v2u gv = *(const v2u*)(P + 3 * PREG + (size_t)m * 1024 + col);
        const f32x4 nw = *(const f32x4*)(A.in[9] + col);
        const float g0 = bflo(gv.x), g1 = bfhi(gv.x), g2 = bflo(gv.y), g3 = bfhi(gv.y);
        v2u yo; yo.x = pk2(ov[0] * siluf_(g0) * nw[0], ov[1] * siluf_(g1) * nw[1]); yo.y = pk2(ov[2] * siluf_(g2) * nw[2], ov[3] * siluf_(g3) * nw[3]);
        *(v2u*)(Y + (size_t)m * 2048 + col) = yo;
    }
}
}


__device__ __forceinline__ void final_norm(Frame& F, const Args& A) {
    const int gw = F.vcu * NWAVES + F.wave, NGW = F.G * NWAVES;
    const GAS f32x4* gf = (const GAS f32x4*)A.in[19] + F.lane;
    for (int m = gw; m < MT; m += NGW) {
        GAS f32x4* zr = (GAS f32x4*)(F.out + (size_t)m * DM) + F.lane;
        f32x4 v[4]; float s = 0.f;
#pragma unroll
        for (int j = 0; j < 4; ++j) { v[j] = zr[64 * j]; s += (v[j].x * v[j].x + v[j].y * v[j].y) + (v[j].z * v[j].z + v[j].w * v[j].w); }
        const float rstd = 1.f / sqrtf(wave_sum(s) * (1.f / DM) + EPS);
#pragma unroll
        for (int j = 0; j < 4; ++j) { const f32x4 g = gf[64 * j]; zr[64 * j] = (f32x4){v[j].x * rstd * g.x, v[j].y * rstd * g.y, v[j].z * rstd * g.z, v[j].w * rstd * g.w}; }
    }
}

__global__ void __launch_bounds__(NWAVES * 64, 2) fwd_kernel(Args args) {
    extern __shared__ __attribute__((aligned(16))) unsigned char lds[];
    Frame F;
    F.lds = (LAS unsigned char*)lds;
    F.MISC = (volatile LAS unsigned*)(F.lds + MISC_OFF);
    F.tid = threadIdx.x; F.lane = F.tid & 63; F.wave = __builtin_amdgcn_readfirstlane(F.tid >> 6);
    F.G = gridDim.x; { const int bx = blockIdx.x; F.vcu = (F.G % 8 == 0) ? (bx % 8) * (F.G / 8) + bx / 8 : bx; }
    F.out = args.out; F.ws = args.ws;
    F.ctl = (gu32*)(args.ws + WS_CTL);
    for (int u = F.tid; u < (LDS_BYTES - LDSCTL_OFF) / 4; u += NWAVES * 64) ((LAS unsigned*)(F.lds + LDSCTL_OFF))[u] = 0u;
    __syncthreads();
    XcdBarrier bar; bar.bar = (unsigned*)(F.ctl + CW_BAR); bar.x = 0; bar.st = nullptr;
    if (N_LAUNCHES != PER_PHASE) bar = xcd_barrier_post((unsigned*)(F.ctl + CW_BAR), F.MISC + 8);
#define GRID_BAR() do { if (N_LAUNCHES != PER_PHASE) xcd_barrier(bar); } while (0)
    const int lo = args.ph_lo, hi = args.ph_hi;
#ifndef PHASE_MASK
#define PHASE_MASK 0xff
#endif
#define IN(k) (((PHASE_MASK >> (k)) & 1) && lo <= (k) && (k) < hi)
#define BOTH(k) (IN(k) && IN((k) + 1))

    if (IN(0)) { p0_prologue(F, args); if (BOTH(0)) GRID_BAR(); }

    if (IN(1)) {
        pg8::Gemm g{(const pg8::bf16_t*)(F.ws + WS_XN), (const pg8::bf16_t*)(F.ws + WS_WIN), MT, NPROJ, DM};
        pg8::StaticOrder S; S.init(MT, NPROJ, F.G, (int)blockIdx.x);
        pg8::EpiProj E{(pg8::bf16_t*)(F.ws + WS_P), F.out};
        pg8::gemm_phase<pg8::EpiProj, pg8::StaticOrder, PG8_ALIGN, PG8_SP2>(F.lds + RING_OFF, g, S, E);
        if (BOTH(1)) GRID_BAR();
    }

    if (IN(2)) {
#ifndef P2_MASK
#define P2_MASK 15
#endif
        if (P2_MASK & 1) for (int u = F.vcu; u < 144; u += F.G) {
            if (u < 128) lru::lru_unit(F, args, u & 15, (u >> 4) * SEQ, SEQ, SEQ, false, u >> 4);
            else lru::lru_unit(F, args, u - 128, MP, MS, DECT, true, 0);
        }
        att::BgCopy bg;
        { const unsigned per = (att::N4 + (unsigned)F.G - 1u) / (unsigned)F.G, lo = (unsigned)F.vcu * per, hi = (lo + per < att::N4) ? lo + per : att::N4;
          const unsigned pw = (((hi - lo) + 7u) / 8u + 127u) & ~127u;
          unsigned c0 = lo + (unsigned)F.wave * pw, c1 = c0 + pw; if (c0 > hi) c0 = hi; if (c1 > hi) c1 = hi;
          bg.cur = (P2_MASK & 8) ? c0 : c1; bg.end = c1; bg.pend0 = 0; bg.pend1 = 0; }
        if (P2_MASK & 2) {
            const unsigned myq = xb_xcc_id() & 7u;
            for (unsigned qi = 0; qi < 8u; ++qi) {
                const unsigned q = (myq + qi) & 7u;
                for (;;) {
                    if (F.tid == 0) F.MISC[17] = __hip_atomic_fetch_add((unsigned*)(F.ctl + CW_QA + 64 * q), 1u, __ATOMIC_RELAXED, __HIP_MEMORY_SCOPE_AGENT);
                    __syncthreads();
                    const unsigned idx = F.MISC[17];
                    __syncthreads();
                    if (idx >= 128u) break;
                    const int J = 7 - (int)(idx >> 4), bh = (int)(q * 16u + (idx & 15u));
                    att::attn_unit(F, args, bh >> 4, bh & 15, J, bg);
                }
            }
        }
        if (P2_MASK & 4) for (int u = F.vcu; u < 256; u += F.G) smp::unit(F, args, u >> 3, u & 7);
        if (P2_MASK & 8) copy_phase(F, args, bg);
        if (BOTH(2)) GRID_BAR();
    }

    if (IN(3)) {
        pg8::Gemm g{(const pg8::bf16_t*)(F.ws + WS_Y), (const pg8::bf16_t*)(F.ws + WS_WOUT), MT, DM, DMIX};
        pg8::StaticOrder S; S.init(MT, DM, F.G, (int)blockIdx.x);
        LAS float* rs = (LAS float*)(F.lds + RS_OFF);
        {
            const float* SSQ = (const float*)(F.ws + WS_SSQ);
            pg8::Unit uu;
            for (int i = 0; i < 2; ++i) if (S.next(i, uu)) {
                if (F.tid < 256) { const float* sp = SSQ + ((size_t)uu.pm * 256 + F.tid) * 32; float sa = 0.f, sl = 0.f;
#pragma unroll
                    for (int k = 0; k < 16; ++k) { sa += sp[k]; sl += sp[16 + k]; }
                    const float ra = 1.f / sqrtf(sa * (1.f / 1024.f) + EPS), rl = 1.f / sqrtf(sl * (1.f / 1024.f) + EPS);
                    rs[i * 512 + F.tid * 2] = ra / rl; rs[i * 512 + F.tid * 2 + 1] = rl; }
            }
        }
        __syncthreads();
        pg8::EpiOut E{args.in[0], args.in[1], F.out, (const PG8_LAS float*)rs};
        pg8::gemm_phase<pg8::EpiOut, pg8::StaticOrder, PG8_ALIGN, PG8_SP2>(F.lds + RING_OFF, g, S, E);
        if (BOTH(3)) GRID_BAR();
    }

    if (IN(4)) { final_norm(F, args); }
#undef IN
#undef BOTH
#undef GRID_BAR
}

extern "C" void kernel_launch(void* const* d_in, const int* in_sizes, int n_in, void* d_out, int out_size, void* d_ws, size_t ws_size, hipStream_t stream) {
    static int grid = 0;
    if (grid == 0) {
        if (n_in != 20 || ws_size < WS_END) { fprintf(stderr, "kernel_launch: unexpected n_in %d / ws %zu\n", n_in, ws_size); grid = -1; return; }
        int dev = 0, cus = 0, per_cu = 0;
        if (hipGetDevice(&dev) != hipSuccess || hipDeviceGetAttribute(&cus, hipDeviceAttributeMultiprocessorCount, dev) != hipSuccess) { grid = -1; return; }
        if (hipFuncSetAttribute((const void*)fwd_kernel, hipFuncAttributeMaxDynamicSharedMemorySize, LDS_BYTES) != hipSuccess) { fprintf(stderr, "kernel_launch: hipFuncSetAttribute failed\n"); grid = -1; return; }
        if (hipOccupancyMaxActiveBlocksPerMultiprocessor(&per_cu, (const void*)fwd_kernel, NWAVES * 64, LDS_BYTES) != hipSuccess || per_cu < 1)
            fprintf(stderr, "kernel_launch: note: occupancy query reports %d workgroups per CU\n", per_cu);
        (void)hipGetLastError();
        grid = cus;
    }
    if (grid < 0) return;
    if (N_LAUNCHES != PER_PHASE) { if (hipMemsetAsync((char*)d_ws + WS_CTL, 0, CTL_ZERO_BYTES, stream) != hipSuccess) return; }
    else { if (hipMemsetAsync((char*)d_ws + WS_CTL, 0, CTL_ZERO_BYTES, stream) != hipSuccess) return; }
    Args a{};
    for (int i = 0; i < 20; ++i) a.in[i] = (const float*)d_in[i];
    a.out = (float*)d_out; a.ws = (unsigned char*)d_ws;
    if (N_LAUNCHES == 1) {
        a.ph_lo = 0; a.ph_hi = PER_PHASE; a.li = 0;
        hipLaunchKernelGGL(fwd_kernel, dim3(grid), dim3(NWAVES * 64), LDS_BYTES, stream, a);
    } else {
        for (int li = 0; li < PER_PHASE; ++li) { a.ph_lo = li; a.ph_hi = li + 1; a.li = li;
            hipLaunchKernelGGL(fwd_kernel, dim3(grid), dim3(NWAVES * 64), LDS_BYTES, stream, a); }
    }
}
```

```cpp
#include <hip/hip_runtime.h>
#include <hip/hip_bf16.h>
#include <cstdio>
#include <cstdint>
#include <cmath>

#ifndef MK_N_LAUNCHES
#define MK_N_LAUNCHES 1
#endif

constexpr int DM = 1024, NBATCH = 8, SEQ = 2048, DECB = 32, DECT = 8, WBK = 2048, NHEAD = 16, HDIM = 64;
constexpr int MP = NBATCH * SEQ;
constexpr int MS = DECB * DECT;
constexpr int MT = MP + MS;
constexpr int NPROJ = 6144, DMIX = 2048;
constexpr float EPS = 1e-6f;
constexpr float LOG2E = 1.4426950408889634f;
constexpr float QSCALE = 0.125f * LOG2E;
constexpr size_t O_YP = 0, O_YS = 16777216, O_KP = 17039360, O_VP = 33816576, O_CP = 50593792, O_LP = 50618368,
                 O_KS = 50626560, O_VS = 117735424, O_CS = 184844288, O_LS = 184942592;
constexpr size_t MiB = 1u << 20;
constexpr size_t WS_CTL = 0, CTL_ZERO_BYTES = 1 * MiB;
constexpr size_t WS_WIN = 2 * MiB;
constexpr size_t WS_WOUT = 14 * MiB;
constexpr size_t WS_WG = 18 * MiB;
constexpr size_t WS_TAB = 19 * MiB;
constexpr size_t WS_XN = 32 * MiB;
constexpr size_t WS_P = 66 * MiB;
constexpr size_t WS_Y = 261 * MiB;
constexpr size_t WS_SSQ = 326 * MiB;
constexpr size_t WS_SPO = 330 * MiB;
constexpr size_t WS_SPM = 339 * MiB;
constexpr size_t WS_END = 341 * MiB;
constexpr size_t PREG = (size_t)MT * 1024;
constexpr int TAB_BT = 0, TAB_LA0 = 16 * 3 * 132;

namespace pg8 {
#define PG8_LAS __attribute__((address_space(3)))
typedef unsigned short bf16_t;
typedef short bf16x8 __attribute__((ext_vector_type(8)));
typedef float f32x4 __attribute__((ext_vector_type(4)));
typedef unsigned u32x4 __attribute__((ext_vector_type(4)));
constexpr int BM = 256, BK = 64, HALF = 128, HTB = HALF * BK * 2  , STAGE_BYTES = 8 * HTB, NXCD = 8, WGM = 8;

__host__ __device__ __forceinline__ int lds_byte(int r, int c) { const int st = (r >> 4) * 2 + (c >> 5), rr = r & 15, cc = c & 31, ob = rr * 64 + cc * 2; return st * 1024 + (ob ^ (((ob >> 9) & 1) << 5)); }
__host__ __device__ __forceinline__ void stage_rc(int b, int& R, int& C) { const int st = b / 1024, sb = b % 1024, swz = sb ^ (((sb >> 9) & 1) << 5); R = (st >> 1) * 16 + swz / 64; C = (st & 1) * 32 + (swz % 64) / 2; }
__host__ __device__ __forceinline__ int perm32(int rho) { const int n = rho >> 4, i = rho & 15; return 8 * (i >> 2) + 4 * n + (i & 3); }

struct Unit { int pm, pn; };
struct Gemm { const bf16_t* A; const bf16_t* Bt; int M, N, K; };

struct StaticOrder {
    int nM, nN, nwg, G, c;
    __host__ __device__ void init(int M, int N, int G_, int c_) { nM = M / BM; nN = N / BM; nwg = nM * nN; G = G_; c = c_; }
    __host__ __device__ bool next(int i, Unit& u) const {
        const long L = (long)i * G + c; if (L >= nwg) return false;
        int wgid = (int)L; { const int q = nwg / NXCD, r = nwg % NXCD, xcd = wgid % NXCD, off = wgid / NXCD; wgid = (xcd < r ? xcd * (q + 1) : r * (q + 1) + (xcd - r) * q) + off; }
        const int nig = WGM * nN, gid = wgid / nig, fm = gid * WGM, gsz = (nM - fm) < WGM ? (nM - fm) : WGM;
        u.pm = fm + ((wgid % nig) % gsz); u.pn = (wgid % nig) / gsz; return true;
    }
    __device__ __forceinline__ void a_ready(const Unit&) const {}
    __device__ __forceinline__ void done(const Unit&) const {}
};

__device__ __forceinline__ unsigned cvt_pk_bf16(float lo, float hi) { unsigned r; asm volatile("v_cvt_pk_bf16_f32 %0, %1, %2" : "=v"(r) : "v"(lo), "v"(hi)); return r; }

struct EpiProj {
    static constexpr bool PERM = true, AFTER_DRAIN = false, MID = false;
    bf16_t* P; float* out;
    __device__ __forceinline__ void mid(f32x4 (&)[2][2][4][2], int, int, int) const {}
    __device__ __forceinline__ void operator()(const f32x4 (&acc)[2][2][4][2], const Unit& u, int ui, int wr, int wc, int fr, int fq) const {
        const int t = u.pn >> 2;
        const int colr = (u.pn & 3) * BM + wc * 32 + 8 * fq;
        const float sc = (t == 0) ? QSCALE : 1.f;
        bf16_t* base = P + (size_t)t * PREG;
        const bool smp = (u.pm == (MP / BM));
        float* fo = nullptr;
        if (t == 1) fo = out + (smp ? O_KS : O_KP); else if (t == 2) fo = out + (smp ? O_VS : O_VP);
        const int row0 = u.pm * BM + wr * 64 + fr;
#pragma unroll
        for (int ai = 0; ai < 2; ++ai)
#pragma unroll
            for (int m = 0; m < 4; ++m) {
                const int row = row0 + ai * HALF + m * 16;
                bf16_t* rowp = base + (size_t)row * 1024 + colr;
                size_t frow = (size_t)row;
                if (smp) { const int sr = row - MP; frow = (size_t)(sr >> 3) * 2048 + 2040 + (sr & 7); }
#pragma unroll
                for (int bj = 0; bj < 2; ++bj) {
                    const f32x4 a0 = acc[ai][bj][m][0], a1 = acc[ai][bj][m][1];
                    u32x4 w; w.x = cvt_pk_bf16(a0[0] * sc, a0[1] * sc); w.y = cvt_pk_bf16(a0[2] * sc, a0[3] * sc); w.z = cvt_pk_bf16(a1[0] * sc, a1[1] * sc); w.w = cvt_pk_bf16(a1[2] * sc, a1[3] * sc);
                    *(u32x4*)(rowp + bj * HALF) = w;
                    if (fo) { float* fp = fo + frow * 1024 + colr + bj * HALF; *(f32x4*)fp = a0; *(f32x4*)(fp + 4) = a1; }
                }
            }
    }
};

struct EpiOut {
    static constexpr bool PERM = false, AFTER_DRAIN = false, MID = true;
    const float* xp; const float* xs; float* out; const PG8_LAS float* rs;
    __device__ __forceinline__ void mid(f32x4 (&acc)[2][2][4][2], int ui, int wr, int fr) const {
        const PG8_LAS float* t = rs + (ui & 1) * 512;
#pragma unroll
        for (int ai = 0; ai < 2; ++ai)
#pragma unroll
            for (int m = 0; m < 4; ++m) { const float f = t[(ai * HALF + wr * 64 + m * 16 + fr) * 2];
#pragma unroll
                for (int bj = 0; bj < 2; ++bj)
#pragma unroll
                    for (int n = 0; n < 2; ++n) acc[ai][bj][m][n] = acc[ai][bj][m][n] * f; }
    }
    __device__ __forceinline__ void operator()(const f32x4 (&acc)[2][2][4][2], const Unit& u, int ui, int wr, int wc, int fr, int fq) const {
        const PG8_LAS float* t = rs + (ui & 1) * 512;
        const bool smp = (u.pm == (MP / BM));
        const int col0 = u.pn * BM + wc * 32 + 4 * fq;
#pragma unroll
        for (int ai = 0; ai < 2; ++ai)
#pragma unroll
            for (int m = 0; m < 4; ++m) {
                const int rl = ai * HALF + wr * 64 + m * 16 + fr, row = u.pm * BM + rl;
                const float f = t[rl * 2 + 1];
                const float* xr = smp ? xs + (size_t)(row - MP) * 1024 : xp + (size_t)row * 1024;
                float* orow = out + (size_t)row * 1024;
#pragma unroll
                for (int bj = 0; bj < 2; ++bj)
#pragma unroll
                    for (int n = 0; n < 2; ++n) { const int c = col0 + bj * HALF + n * 16; const f32x4 xv = *(const f32x4*)(xr + c); *(f32x4*)(orow + c) = xv + acc[ai][bj][m][n] * f; }
            }
    }
};

template <class Epi, class Sched, bool ALIGN_EPI = false, bool SP2 = false>
__device__ __forceinline__ void gemm_phase(PG8_LAS unsigned char* lds, const Gemm g, const Sched& S, const Epi& E) {
    const int tid = threadIdx.x, wid = __builtin_amdgcn_readfirstlane(tid >> 6), lane = tid & 63, wr = wid >> 2, wc = wid & 3, fr = lane & 15, fq = lane >> 4;
    const int K = g.K, nt = K / BK;
    unsigned voffA[2], voffB[2];
#pragma unroll
    for (int i = 0; i < 2; ++i) { int R, C; stage_rc(tid * 16 + i * 8192, R, C); const int Rb = Epi::PERM ? ((R & ~31) + perm32(R & 31)) : R;
        voffA[i] = (unsigned)(R * K + C) * 2u; voffB[i] = (unsigned)(Rb * K + C) * 2u; }
    const size_t kstep = (size_t)(BK * 2);
    const size_t hstep = (size_t)HALF * K * 2;
    const size_t tstep = 2 * hstep;
    const unsigned ldsw = (unsigned)wid * 1024u;
    const int aoff = lds_byte(wr * 64 + fr, fq * 8), boff = lds_byte(wc * 32 + fr, fq * 8);
#define PG8_SA(b, h) (((b) * 2 + (h)) * HTB)
#define PG8_SB(b, h) ((4 + (b) * 2 + (h)) * HTB)
#define PG8_STAGE(bufoff, gbase, voff) do { _Pragma("unroll") for (int _i = 0; _i < 2; ++_i) \
        __builtin_amdgcn_global_load_lds((const unsigned*)((const char*)(gbase) + (voff)[_i]), (PG8_LAS unsigned*)(lds + (bufoff) + ldsw + _i * 8192), 16, 0, 0); } while (0)
#define PG8_LDA(dst, b, h) do { _Pragma("unroll") for (int m = 0; m < 4; ++m) _Pragma("unroll") for (int k = 0; k < 2; ++k) dst[m][k] = *(const PG8_LAS bf16x8*)(lds + PG8_SA(b, h) + aoff + m * 2048 + k * 1024); } while (0)
#define PG8_LDB(dst, b, h) do { _Pragma("unroll") for (int n = 0; n < 2; ++n) _Pragma("unroll") for (int k = 0; k < 2; ++k) dst[n][k] = *(const PG8_LAS bf16x8*)(lds + PG8_SB(b, h) + boff + n * 2048 + k * 1024); } while (0)
#define PG8_MMA(ai, bj, At, Bt) do { __builtin_amdgcn_s_setprio(1); _Pragma("unroll") for (int m = 0; m < 4; ++m) _Pragma("unroll") for (int n = 0; n < 2; ++n) _Pragma("unroll") for (int k = 0; k < 2; ++k) \
        acc[ai][bj][m][n] = __builtin_amdgcn_mfma_f32_16x16x32_bf16(Bt[n][k], At[m][k], acc[ai][bj][m][n], 0, 0, 0); __builtin_amdgcn_s_setprio(0); } while (0)
#define PG8_WAIT_V(n) asm volatile("s_waitcnt vmcnt(" #n ")" ::: "memory")
#define PG8_WAIT_L(n) asm volatile("s_waitcnt lgkmcnt(" #n ")" ::: "memory")
#define PG8_BAR __builtin_amdgcn_s_barrier()
#define PG8_SCHED __builtin_amdgcn_sched_barrier(0)
    Unit cur, nxt; int ui = 0;
    if (!S.next(0, cur)) return;
    f32x4 acc[2][2][4][2];
#pragma unroll
    for (int a = 0; a < 2; ++a)
#pragma unroll
        for (int b = 0; b < 2; ++b)
#pragma unroll
            for (int m = 0; m < 4; ++m)
#pragma unroll
                for (int n = 0; n < 2; ++n) acc[a][b][m][n] = (f32x4){0.f, 0.f, 0.f, 0.f};
    bf16x8 At[4][2], B0[2][2], B1[2][2];
    const char* cA = (const char*)g.A + (size_t)cur.pm * tstep; const char* cB = (const char*)g.Bt + (size_t)cur.pn * tstep;
    S.a_ready(cur);
    if constexpr (SP2) {
        PG8_STAGE(PG8_SB(0, 0), cB, voffB); PG8_STAGE(PG8_SB(0, 1), cB + hstep, voffB); PG8_STAGE(PG8_SA(0, 0), cA, voffA); PG8_STAGE(PG8_SA(0, 1), cA + hstep, voffA);
        if (wr == 1) PG8_BAR;
        PG8_WAIT_V(2); PG8_BAR;
        PG8_STAGE(PG8_SB(1, 0), cB + kstep, voffB); PG8_STAGE(PG8_SA(1, 0), cA + kstep, voffA); PG8_STAGE(PG8_SB(1, 1), cB + hstep + kstep, voffB);
        PG8_WAIT_V(6); PG8_BAR;
    } else {
        PG8_STAGE(PG8_SB(0, 0), cB, voffB); PG8_STAGE(PG8_SA(0, 0), cA, voffA); PG8_STAGE(PG8_SB(0, 1), cB + hstep, voffB); PG8_STAGE(PG8_SA(0, 1), cA + hstep, voffA);
        if (wr == 1) PG8_BAR;
        PG8_WAIT_V(4); PG8_BAR;
        PG8_STAGE(PG8_SB(1, 0), cB + kstep, voffB); PG8_STAGE(PG8_SA(1, 0), cA + kstep, voffA); PG8_STAGE(PG8_SB(1, 1), cB + hstep + kstep, voffB);
        PG8_WAIT_V(6); PG8_BAR;
    }
    for (;;) {
        const bool has_next = S.next(ui + 1, nxt);
        const char* nA = has_next ? (const char*)g.A + (size_t)nxt.pm * tstep : cA; const char* nB = has_next ? (const char*)g.Bt + (size_t)nxt.pn * tstep : cB;
        for (int t = 0; t < nt; t += 2) {
            if constexpr (Epi::MID) { if (t == (nt >> 1)) E.mid(acc, ui, wr, fr); }
            const bool last = (t == nt - 2);
            const char* a1 = cA + (size_t)(t + 1) * kstep;
            const char* a2 = last ? nA : cA + (size_t)(t + 2) * kstep; const char* b2 = last ? nB : cB + (size_t)(t + 2) * kstep;
            const char* a3 = a2 + kstep; const char* b3 = b2 + kstep;
            if (last && has_next) S.a_ready(nxt);
            if constexpr (SP2) {
            PG8_LDB(B0, 0, 0); PG8_LDB(B1, 0, 1); PG8_SCHED; PG8_LDA(At, 0, 0); PG8_STAGE(PG8_SA(1, 1), a1 + hstep, voffA);
            PG8_WAIT_V(8); PG8_WAIT_L(0); PG8_BAR; PG8_MMA(0, 0, At, B0); PG8_MMA(0, 1, At, B1); PG8_BAR; PG8_SCHED;
            PG8_LDA(At, 0, 1); PG8_STAGE(PG8_SB(0, 0), b2, voffB); PG8_STAGE(PG8_SB(0, 1), b2 + hstep, voffB); PG8_STAGE(PG8_SA(0, 0), a2, voffA);
            PG8_WAIT_V(8); PG8_WAIT_L(0); PG8_BAR; PG8_MMA(1, 0, At, B0); PG8_MMA(1, 1, At, B1); PG8_BAR; PG8_SCHED;
            PG8_LDB(B0, 1, 0); PG8_LDB(B1, 1, 1); PG8_SCHED; PG8_LDA(At, 1, 0); PG8_STAGE(PG8_SA(0, 1), a2 + hstep, voffA);
            PG8_WAIT_V(8); PG8_WAIT_L(0); PG8_BAR; PG8_MMA(0, 0, At, B0); PG8_MMA(0, 1, At, B1); PG8_BAR; PG8_SCHED;
            PG8_LDA(At, 1, 1); PG8_STAGE(PG8_SB(1, 0), b3, voffB); PG8_STAGE(PG8_SB(1, 1), b3 + hstep, voffB); PG8_STAGE(PG8_SA(1, 0), a3, voffA);
            PG8_WAIT_V(8); PG8_WAIT_L(0); PG8_BAR; PG8_MMA(1, 0, At, B0); PG8_MMA(1, 1, At, B1); PG8_BAR; PG8_SCHED;
            } else {
            PG8_LDB(B0, 0, 0); PG8_SCHED; PG8_LDA(At, 0, 0); PG8_STAGE(PG8_SA(1, 1), a1 + hstep, voffA);
            PG8_WAIT_L(8); PG8_BAR; PG8_WAIT_L(0); PG8_MMA(0, 0, At, B0); PG8_BAR; PG8_SCHED;
            PG8_LDB(B1, 0, 1); PG8_STAGE(PG8_SB(0, 0), b2, voffB);
            PG8_BAR; PG8_WAIT_L(0); PG8_MMA(0, 1, At, B1); PG8_BAR;
            PG8_LDA(At, 0, 1); PG8_STAGE(PG8_SA(0, 0), a2, voffA);
            PG8_BAR; PG8_WAIT_L(0); PG8_MMA(1, 0, At, B0); PG8_BAR; PG8_SCHED;
            PG8_STAGE(PG8_SB(0, 1), b2 + hstep, voffB);
            PG8_WAIT_V(6); PG8_BAR; PG8_MMA(1, 1, At, B1); PG8_BAR;
            PG8_LDB(B0, 1, 0); PG8_SCHED; PG8_LDA(At, 1, 0); PG8_STAGE(PG8_SA(0, 1), a2 + hstep, voffA);
            PG8_WAIT_L(8); PG8_BAR; PG8_WAIT_L(0); PG8_MMA(0, 0, At, B0); PG8_BAR; PG8_SCHED;
            PG8_LDB(B1, 1, 1); PG8_STAGE(PG8_SB(1, 0), b3, voffB);
            PG8_BAR; PG8_WAIT_L(0); PG8_MMA(0, 1, At, B1); PG8_BAR;
            PG8_LDA(At, 1, 1); PG8_STAGE(PG8_SA(1, 0), a3, voffA);
            PG8_BAR; PG8_WAIT_L(0); PG8_MMA(1, 0, At, B0); PG8_BAR; PG8_SCHED;
            PG8_STAGE(PG8_SB(1, 1), b3 + hstep, voffB);
            PG8_WAIT_V(6); PG8_BAR; PG8_MMA(1, 1, At, B1); PG8_BAR;
            }
        }
        if constexpr (ALIGN_EPI) { if (wr == 0) PG8_BAR; }
        if constexpr (!Epi::AFTER_DRAIN) { E(acc, cur, ui, wr, wc, fr, fq); S.done(cur); }
        if (!has_next) break;
#pragma unroll
        for (int a = 0; a < 2; ++a)
#pragma unroll
            for (int b = 0; b < 2; ++b)
#pragma unroll
                for (int m = 0; m < 4; ++m)
#pragma unroll
                    for (int n = 0; n < 2; ++n) acc[a][b][m][n] = (f32x4){0.f, 0.f, 0.f, 0.f};
        cur = nxt; cA = nA; cB = nB; ++ui;
        if constexpr (ALIGN_EPI) { if (wr == 1) PG8_BAR; }
    }
    PG8_WAIT_V(0);
    if constexpr (!ALIGN_EPI) { if (wr == 0) PG8_BAR; }
    PG8_BAR;
    if constexpr (Epi::AFTER_DRAIN) { E.fused(acc, cur, wr, wc, fr, fq, lds, wid, lane); S.done(cur); }
#undef PG8_SA
#undef PG8_SB
#undef PG8_STAGE
#undef PG8_LDA
#undef PG8_LDB
#undef PG8_MMA
#undef PG8_WAIT_V
#undef PG8_WAIT_L
#undef PG8_BAR
#undef PG8_SCHED
}
}

#ifndef PG8_SP2
#define PG8_SP2 true
#endif
#ifndef PG8_ALIGN
#define PG8_ALIGN true
#endif

constexpr int NWAVES = 8;
constexpr int N_LAUNCHES = MK_N_LAUNCHES;
constexpr int PER_PHASE = 5;
constexpr int CW_TMO = 0, CW_CODE = 1;
constexpr int CW_BAR = 4096;
constexpr int CW_QA = 8192;
constexpr int CW_SCNT = 16384;
constexpr int RING_OFF = 0, RING_BYTES = 131072;
constexpr int LDSCTL_OFF = RING_BYTES, MISC_OFF = LDSCTL_OFF + 320;
constexpr int RS_OFF = RING_BYTES + 1024;
constexpr int LDS_BYTES = 147456;

#define GAS __attribute__((address_space(1)))
#define LAS __attribute__((address_space(3)))
typedef unsigned short bf16;
typedef unsigned v4u __attribute__((ext_vector_type(4)));
typedef unsigned v2u __attribute__((ext_vector_type(2)));
typedef float f32x4 __attribute__((ext_vector_type(4)));
typedef float f32x16 __attribute__((ext_vector_type(16)));
typedef short bf16x8 __attribute__((ext_vector_type(8)));
typedef short s16x4 __attribute__((ext_vector_type(4)));
typedef GAS unsigned gu32;
typedef GAS unsigned long long gu64;
#define RLX_AGENT __ATOMIC_RELAXED, __HIP_MEMORY_SCOPE_AGENT
#define LDS_WAIT() asm volatile("s_waitcnt lgkmcnt(0)" ::: "memory")
#define VM_WAIT() asm volatile("s_waitcnt vmcnt(0)" ::: "memory")
__device__ __forceinline__ unsigned f2bf(float f) { unsigned u = __builtin_bit_cast(unsigned, f); return (u + 0x7fffu + ((u >> 16) & 1u)) >> 16; }
__device__ __forceinline__ unsigned pk2(float lo, float hi) { return f2bf(lo) | (f2bf(hi) << 16); }
__device__ __forceinline__ float bflo(unsigned w) { return __builtin_bit_cast(float, w << 16); }
__device__ __forceinline__ float bfhi(unsigned w) { return __builtin_bit_cast(float, w & 0xffff0000u); }
__device__ __forceinline__ float bf1(unsigned short h) { return __builtin_bit_cast(float, (unsigned)h << 16); }
__device__ __forceinline__ float ex2(float x) { return __builtin_amdgcn_exp2f(x); }
__device__ __forceinline__ float lg2(float x) { return __builtin_amdgcn_logf(x); }
__device__ __forceinline__ float rcpf_(float x) { return __builtin_amdgcn_rcpf(x); }
__device__ __forceinline__ float sigmoidf_(float x) { return rcpf_(1.f + ex2(-x * LOG2E)); }
__device__ __forceinline__ float siluf_(float x) { return x * sigmoidf_(x); }

#define XB_TMO      128
#define XB_XCNT(j)  (256  + 64 * (j))
#define XB_XSUB(j)  (1280 + 64 * (j))
#define XB_XGEN(j)  (2304 + 64 * (j))
#define XB_TOP      3328
#define XB_TOPGEN   3392
#define XCD_BAR_WORDS 3456
#define XB_SPIN_CAP (1u << 18)

__device__ __forceinline__ unsigned xb_ld(unsigned* p)              { return __hip_atomic_load(p, __ATOMIC_RELAXED, __HIP_MEMORY_SCOPE_AGENT); }
__device__ __forceinline__ unsigned xb_add(unsigned* p, unsigned v) { return __hip_atomic_fetch_add(p, v, __ATOMIC_RELAXED, __HIP_MEMORY_SCOPE_AGENT); }
__device__ __forceinline__ unsigned xb_xcc_id() { return (unsigned)__builtin_amdgcn_s_getreg((3 << 11) | 20) & 0xFu; }
#define XB_SPIN(cond, bar) do { unsigned _sp = 0; while (cond) { __builtin_amdgcn_s_sleep(1); \
    if ((++_sp & 255u) == 0u) { if (xb_ld(&(bar)[XB_TMO])) break; if (_sp > XB_SPIN_CAP) { atomicAdd(&(bar)[XB_TMO], 1u); break; } } } } while (0)

struct XcdBarrier {
    unsigned* bar; unsigned x;
    volatile LAS unsigned* st;
};

__device__ __forceinline__ XcdBarrier xcd_barrier_post(unsigned* bar, volatile LAS unsigned* st) {
    XcdBarrier b; b.bar = bar; b.x = xb_xcc_id(); b.st = st;
    if (threadIdx.x == 0) (void)xb_add(&bar[XB_XCNT(b.x)], 1u);
    return b;
}
__device__ __forceinline__ void xcd_barrier_complete(unsigned* bar, unsigned x, unsigned& nloc, unsigned& nx) {
    const unsigned G = gridDim.x * gridDim.y * gridDim.z;
    unsigned sum, cnt, mine, sp = 0u;
    for (;;) {
        sum = 0u; cnt = 0u; mine = 0u;
#pragma unroll
        for (unsigned j = 0; j < 16; ++j) { const unsigned c = xb_ld(&bar[XB_XCNT(j)]); sum += c; cnt += (c > 0u) ? 1u : 0u; mine = (j == x) ? c : mine; }
        if (sum == G) break;
        __builtin_amdgcn_s_sleep(1);
        if ((++sp & 255u) == 0u) { if (xb_ld(&bar[XB_TMO])) break; if (sp > XB_SPIN_CAP) { atomicAdd(&bar[XB_TMO], 1u); break; } }
    }
    nloc = mine > 0u ? mine : 1u; nx = cnt > 0u ? cnt : 1u;
}

__device__ __forceinline__ void xcd_barrier(const XcdBarrier& b) {
    asm volatile("s_waitcnt vmcnt(0)" ::: "memory");
    __syncthreads();
    if (threadIdx.x == 0) {
        unsigned* bar = b.bar;
        __builtin_amdgcn_s_waitcnt(0);
        unsigned nloc = b.st[0], nx = b.st[1];
        if (nloc == 0u) { xcd_barrier_complete(bar, b.x, nloc, nx); b.st[0] = nloc; b.st[1] = nx; }
        const unsigned old = xb_add(&bar[XB_XSUB(b.x)], 1u);
        const unsigned gen = old / nloc;
        if (old + 1u == (gen + 1u) * nloc) {
            __builtin_amdgcn_fence(__ATOMIC_RELEASE, "agent");
            asm volatile("s_waitcnt vmcnt(0)" ::: "memory");
            const unsigned og = xb_add(&bar[XB_TOP], 1u);
            const unsigned tg = og / nx;
            if (og + 1u == (tg + 1u) * nx) xb_add(&bar[XB_TOPGEN], 1u);
            else XB_SPIN(xb_ld(&bar[XB_TOPGEN]) == tg, bar);
            __builtin_amdgcn_fence(__ATOMIC_ACQUIRE, "agent");
            xb_add(&bar[XB_XGEN(b.x)], 1u);
            asm volatile("s_waitcnt vmcnt(0)" ::: "memory");
        } else {
            XB_SPIN(xb_ld(&bar[XB_XGEN(b.x)]) == gen, bar);
            __builtin_amdgcn_fence(__ATOMIC_ACQUIRE, "agent");
            asm volatile("s_waitcnt vmcnt(0)" ::: "memory");
        }
    }
    __syncthreads();
}

struct Args { const float* in[20]; float* out; unsigned char* ws; int ph_lo, ph_hi, li, pad; };
struct Frame {
    LAS unsigned char* lds;
    volatile LAS unsigned* MISC;
    gu32* ctl;
    int tid, lane, wave;
    int vcu, G;
    float* out;
    unsigned char* ws;
};
__device__ __forceinline__ float wave_sum(float v) {
#pragma unroll
    for (int o = 1; o < 64; o <<= 1) v += __shfl_xor(v, o);
    return v;
}

__device__ __forceinline__ void p0_transpose_item(const float* W, int K, int N, bf16* WT, LAS float* scr, int item, int lane) {
    const int nblk = N / 32, kb = item / nblk, nb = item % nblk, k0 = 64 * kb, n0 = 32 * nb;
    f32x4 v[8];
#pragma unroll
    for (int i = 0; i < 8; ++i) v[i] = *(const f32x4*)(W + (size_t)(k0 + (lane >> 3) + 8 * i) * N + n0 + 4 * (lane & 7));
#pragma unroll
    for (int i = 0; i < 8; ++i) { LAS float* d = scr + ((lane >> 3) + 8 * i) * 33 + 4 * (lane & 7); d[0] = v[i][0]; d[1] = v[i][1]; d[2] = v[i][2]; d[3] = v[i][3]; }
    LDS_WAIT(); asm volatile("" ::: "memory");
    const int c = lane & 7;
#pragma unroll
    for (int j = 0; j < 4; ++j) { const int n = (lane >> 3) + 8 * j; const LAS float* s = scr + (8 * c) * 33 + n;
        v4u o; o.x = pk2(s[0 * 33], s[1 * 33]); o.y = pk2(s[2 * 33], s[3 * 33]); o.z = pk2(s[4 * 33], s[5 * 33]); o.w = pk2(s[6 * 33], s[7 * 33]);
        *(GAS v4u*)(WT + (size_t)(n0 + n) * K + k0 + 8 * c) = o; }
    LDS_WAIT(); asm volatile("" ::: "memory");
}
__device__ __forceinline__ int t5_bucket(int d) {
    if (d < 16) return d;
    int b = 15;
    const int thr[16] = {16, 22, 30, 40, 54, 73, 99, 134, 182, 246, 332, 450, 609, 825, 1117, 1513};
#pragma unroll
    for (int i = 0; i < 16; ++i) b += (d >= thr[i]) ? 1 : 0;
    return b;
}
__device__ __forceinline__ void p0_prologue(Frame& F, const Args& A) {
    LAS float* scr = (LAS float*)(F.lds + RING_OFF + F.wave * 16384);
    const int gw = F.vcu * NWAVES + F.wave, NGW = F.G * NWAVES;
    constexpr int I_IN = (DM / 64) * (NPROJ / 32), I_OUT = (DMIX / 64) * (DM / 32), I_G = 16 * 2;
    constexpr int NITEMS = I_IN + I_OUT + 2 * I_G;
    bf16* WIN = (bf16*)(F.ws + WS_WIN); bf16* WOUT = (bf16*)(F.ws + WS_WOUT); bf16* WG = (bf16*)(F.ws + WS_WG);
    for (int it = gw; it < NITEMS; it += NGW) {
        int r = it;
        if (r < I_IN) { p0_transpose_item(A.in[8], DM, NPROJ, WIN, scr, r, F.lane); continue; } r -= I_IN;
        if (r < I_OUT) { p0_transpose_item(A.in[18], DMIX, DM, WOUT, scr, r, F.lane); continue; } r -= I_OUT;
        if (r < I_G) { const int blk = r >> 1; p0_transpose_item(A.in[13] + blk * 4096, 64, 64, WG + (blk * 2 + 0) * 4096, scr, r & 1, F.lane); continue; } r -= I_G;
        { const int blk = r >> 1; p0_transpose_item(A.in[15] + blk * 4096, 64, 64, WG + (blk * 2 + 1) * 4096, scr, r & 1, F.lane); }
    }
    bf16* XN = (bf16*)(F.ws + WS_XN);
    const GAS f32x4* gin = (const GAS f32x4*)A.in[7] + F.lane;
    for (int m0 = gw; m0 < MT; m0 += 2 * NGW) {
        const int m1 = (m0 + NGW < MT) ? m0 + NGW : m0;
        const float* xr0 = (m0 < MP) ? A.in[0] + (size_t)m0 * DM : A.in[1] + (size_t)(m0 - MP) * DM;
        const float* xr1 = (m1 < MP) ? A.in[0] + (size_t)m1 * DM : A.in[1] + (size_t)(m1 - MP) * DM;
        f32x4 v[8]; float s0 = 0.f, s1 = 0.f;
#pragma unroll
        for (int j = 0; j < 4; ++j) { v[j] = ((const GAS f32x4*)xr0)[F.lane + 64 * j]; v[4 + j] = ((const GAS f32x4*)xr1)[F.lane + 64 * j]; }
#pragma unroll
        for (int j = 0; j < 4; ++j) { s0 += (v[j].x * v[j].x + v[j].y * v[j].y) + (v[j].z * v[j].z + v[j].w * v[j].w); s1 += (v[4 + j].x * v[4 + j].x + v[4 + j].y * v[4 + j].y) + (v[4 + j].z * v[4 + j].z + v[4 + j].w * v[4 + j].w); }
        const float r0 = 1.f / sqrtf(wave_sum(s0) * (1.f / DM) + EPS), r1 = 1.f / sqrtf(wave_sum(s1) * (1.f / DM) + EPS);
        GAS unsigned long long* o0 = (GAS unsigned long long*)(XN + (size_t)m0 * DM) + F.lane;
        GAS unsigned long long* o1 = (GAS unsigned long long*)(XN + (size_t)m1 * DM) + F.lane;
#pragma unroll
        for (int j = 0; j < 4; ++j) { const f32x4 g = gin[64 * j];
            o0[64 * j] = (unsigned long long)pk2(v[j].x * r0 * g.x, v[j].y * r0 * g.y) | ((unsigned long long)pk2(v[j].z * r0 * g.z, v[j].w * r0 * g.w) << 32);
            o1[64 * j] = (unsigned long long)pk2(v[4 + j].x * r1 * g.x, v[4 + j].y * r1 * g.y) | ((unsigned long long)pk2(v[4 + j].z * r1 * g.z, v[4 + j].w * r1 * g.w) << 32); }
    }
    float* TAB = (float*)(F.ws + WS_TAB);
    const int gt = F.vcu * (NWAVES * 64) + F.tid, NGT = F.G * NWAVES * 64;
    for (int i = gt; i < 16 * 3 * 132; i += NGT) {
        const int h = i / 396, rem = i % 396, p = rem / 132, s = rem % 132;
        const int sc = s > 128 ? 128 : s;
        TAB[TAB_BT + i] = A.in[6][t5_bucket(sc << (2 * p)) * 16 + h] * LOG2E;
    }
    for (int i = gt; i < 1024; i += NGT) {
        const float x = -A.in[17][i];
        TAB[TAB_LA0 + i] = -8.f * (fmaxf(x, 0.f) + log1pf(expf(-fabsf(x))));
    }
}


#ifndef BG_ON
#define BG_ON 0
#endif
namespace att {
constexpr int A_ACCO = 0;
constexpr int A_ACCL = 32768;
constexpr int A_BT = 33792;
constexpr int A_NEG = A_BT + 3 * 1024;
constexpr int A_WS = 37376;
constexpr int A_KV = 41472;
constexpr int A_END = A_KV + 8 * 8192;
constexpr float THR = 8.0f;
__device__ __forceinline__ int crow(int r, int hi) { return (r & 3) + 8 * (r >> 2) + 4 * hi; }
typedef short v4i16_t __attribute__((ext_vector_type(4)));
__device__ __forceinline__ s16x4 vtr(const LAS unsigned char* p) { return __builtin_bit_cast(s16x4, __builtin_amdgcn_ds_read_tr16_b64_v4i16((LAS v4i16_t*)p)); }
typedef float f32x2_t __attribute__((ext_vector_type(2))); typedef __bf16 bf16x2_t __attribute__((ext_vector_type(2)));
__device__ __forceinline__ unsigned cvtpk(float lo, float hi) { f32x2_t v = {lo, hi}; bf16x2_t b = __builtin_convertvector(v, bf16x2_t); return __builtin_bit_cast(unsigned, b); }

struct Geo { int dil, im, hb, res; };
__device__ __forceinline__ int tok_of(const Geo& g, int p0, int i) { return g.dil * (p0 + (i & g.im)) + g.res + ((i >> 4) & g.hb); }

struct WaveState { f32x16 o0, o1; float m, l; };

constexpr unsigned GRP4 = 2048u, N4 = 64u * 96u * GRP4;
struct BgCopy { unsigned cur, end; unsigned pend0, pend1; f32x4 a0, a1, b0, b1; f32x4* dump; };
__device__ __forceinline__ const f32x4* bg_src(const float* ck, const float* cv, unsigned ix) { const unsigned g = ix / GRP4, off = ix - g * GRP4, zb = g / 96u, k = g - zb * 96u; return (const f32x4*)(((zb >> 5) ? cv : ck) + ((size_t)(zb & 31u) * 2048 + 16 * k + 8) * 1024) + off; }
__device__ __forceinline__ f32x4* bg_dst(float* out, unsigned ix) { const unsigned g = ix / GRP4, off = ix - g * GRP4, zb = g / 96u, k = g - zb * 96u; return (f32x4*)(out + ((zb >> 5) ? O_VS : O_KS) + ((size_t)(zb & 31u) * 2048 + 16 * k) * 1024) + off; }
template <int SET> __device__ __forceinline__ void bg_step(BgCopy& c, const float* ck, const float* cv, float* out, int lane) {
    const unsigned pend = (unsigned)__builtin_amdgcn_readfirstlane((int)(SET == 0 ? c.pend0 : c.pend1));
    const unsigned cur = (unsigned)__builtin_amdgcn_readfirstlane((int)c.cur), end = (unsigned)__builtin_amdgcn_readfirstlane((int)c.end);
    f32x4* sp = (pend < end) ? bg_dst(out, pend) + lane : c.dump;
    const unsigned ld = (cur < end) ? cur : (end >= 128u ? end - 128u : 0u);
    const f32x4* lp = bg_src(ck, cv, ld) + lane;
    if (SET == 0) { __builtin_nontemporal_store(c.a0, sp); __builtin_nontemporal_store(c.a1, sp + 64); c.a0 = __builtin_nontemporal_load(lp); c.a1 = __builtin_nontemporal_load(lp + 64); c.pend0 = (cur < end) ? cur : end; }
    else          { __builtin_nontemporal_store(c.b0, sp); __builtin_nontemporal_store(c.b1, sp + 64); c.b0 = __builtin_nontemporal_load(lp); c.b1 = __builtin_nontemporal_load(lp + 64); c.pend1 = (cur < end) ? cur : end; }
    c.cur = (cur < end) ? cur + 128u : end;
}
__device__ __forceinline__ void bg_flush(BgCopy& c, float* out, int lane) {
    if (c.pend0 < c.end) { f32x4* sp = bg_dst(out, c.pend0) + lane; __builtin_nontemporal_store(c.a0, sp); __builtin_nontemporal_store(c.a1, sp + 64); c.pend0 = c.end; }
    if (c.pend1 < c.end) { f32x4* sp = bg_dst(out, c.pend1) + lane; __builtin_nontemporal_store(c.b0, sp); __builtin_nontemporal_store(c.b1, sp + 64); c.pend1 = c.end; }
}

struct TileRegs { bf16x8 k[4]; v4u v[4]; };
struct TilePtrs { const char* k; const char* v[4]; };
__device__ __forceinline__ void tile_ptrs(TilePtrs& tp, const bf16* Kh, const bf16* Vh, const Geo& g, int lane) {
    const int r32 = lane & 31, hi = lane >> 5;
    tp.k = (const char*)(Kh + (size_t)tok_of(g, 0, r32) * 1024 + 8 * hi);
#pragma unroll
    for (int i = 0; i < 4; ++i) { const int row = 8 * i + (lane >> 3), cp = lane & 7; const int cv = cp ^ (((row >> 1) & 1) << 2); tp.v[i] = (const char*)(Vh + (size_t)tok_of(g, 0, row) * 1024 + cv * 8); }
}
__device__ __forceinline__ void tile_issue(TileRegs& t, const TilePtrs& tp, long boff) {
#pragma unroll
    for (int ks = 0; ks < 4; ++ks) t.k[ks] = *(const bf16x8*)(tp.k + boff + 32 * ks);
#pragma unroll
    for (int i = 0; i < 4; ++i) t.v[i] = *(const v4u*)(tp.v[i] + boff);
}

__device__ __forceinline__ void tile_compute(WaveState& st, const LAS unsigned char* Qw, const TileRegs& t, const Geo& g, int sbase,
                                             LAS unsigned char* Vw, LAS float* wsf, const LAS float* bt, const LAS float* neg, int lane) {
    const int r32 = lane & 31, hi = lane >> 5;
#pragma unroll
    for (int i = 0; i < 4; ++i) *(LAS v4u*)(Vw + i * 1024 + lane * 16) = t.v[i];
    f32x16 S = {0.f, 0.f, 0.f, 0.f, 0.f, 0.f, 0.f, 0.f, 0.f, 0.f, 0.f, 0.f, 0.f, 0.f, 0.f, 0.f};
#pragma unroll
    for (int ks = 0; ks < 4; ++ks) { const bf16x8 qf = *(const LAS bf16x8*)(Qw + ks * 1024 + lane * 16); S = __builtin_amdgcn_mfma_f32_32x32x16_bf16(t.k[ks], qf, S, 0, 0, 0); }
    {
        const int sq = sbase + (r32 & g.im);
        const int qh = (r32 >> 4) & g.hb;
        const LAS float* bl = bt + (sq + 64 - 15 - 4 * hi);
        const LAS float* b0 = (g.hb && qh != 0) ? neg : bl;
        const LAS float* b1 = (g.hb && qh != 1) ? neg : bl - (g.hb ? 0 : 16);
#pragma unroll
        for (int r = 0; r < 16; ++r) { const int e0 = (r & 3) + 8 * ((r >> 2) & 1);
            S[r] += (r < 8 ? b0 : b1)[15 - e0]; }
    }
    float mx = S[0];
#pragma unroll
    for (int r = 1; r < 16; ++r) mx = fmaxf(mx, S[r]);
    mx = fmaxf(mx, __shfl_xor(mx, 32));
    if (__any(mx > st.m + THR)) {
        const float mn = fmaxf(st.m, mx);
        const float al = ex2(st.m - mn);
        st.l *= al; st.m = mn;
        if (hi == 0) wsf[r32] = al;
        LDS_WAIT();
#pragma unroll
        for (int r = 0; r < 16; ++r) { const float f = wsf[crow(r, hi)]; st.o0[r] *= f; st.o1[r] *= f; }
    }
    float ps = 0.f;
#pragma unroll
    for (int r = 0; r < 16; ++r) { S[r] = ex2(S[r] - st.m); ps += S[r]; }
    st.l += ps;
    const int g16 = lane >> 4, i16 = lane & 15, q4 = i16 >> 2, p4 = i16 & 3;
    const LAS unsigned char* vb = Vw + (4 * hi + q4) * 128 + (((2 * (g16 & 1)) + (p4 >> 1)) << 4) + 8 * (p4 & 1);
    const int xo = (q4 >> 1) * 64;
#pragma unroll
    for (int ks = 0; ks < 2; ++ks) {
        v4u pw; pw.x = cvtpk(S[8 * ks + 0], S[8 * ks + 1]); pw.y = cvtpk(S[8 * ks + 2], S[8 * ks + 3]); pw.z = cvtpk(S[8 * ks + 4], S[8 * ks + 5]); pw.w = cvtpk(S[8 * ks + 6], S[8 * ks + 7]);
        const bf16x8 pa = __builtin_bit_cast(bf16x8, pw);
        const s16x4 a0 = vtr(vb + ks * 2048 + (0 ^ xo)), a1 = vtr(vb + ks * 2048 + 1024 + (0 ^ xo));
        const s16x4 b0 = vtr(vb + ks * 2048 + (64 ^ xo)), b1 = vtr(vb + ks * 2048 + 1024 + (64 ^ xo));
        const bf16x8 v0 = (bf16x8){a0[0], a0[1], a0[2], a0[3], a1[0], a1[1], a1[2], a1[3]};
        const bf16x8 v1 = (bf16x8){b0[0], b0[1], b0[2], b0[3], b1[0], b1[1], b1[2], b1[3]};
        st.o0 = __builtin_amdgcn_mfma_f32_32x32x16_bf16(pa, v0, st.o0, 0, 0, 0);
        st.o1 = __builtin_amdgcn_mfma_f32_32x32x16_bf16(pa, v1, st.o1, 0, 0, 0);
    }
}

__device__ __forceinline__ void merge(LAS unsigned char* base, const WaveState& st, int tl, bool first, bool keep_l, int w, int lane) {
    const int r32 = lane & 31, hi = lane >> 5;
    LAS float* wsf = (LAS float*)(base + A_WS) + w * 128;
    LAS float* accL = (LAS float*)(base + A_ACCL);
    LAS unsigned short* accO = (LAS unsigned short*)(base + A_ACCO);
    const float lt = st.l + __shfl_xor(st.l, 32);
    const float lse = st.m + lg2(lt);
    const float rl = rcpf_(lt);
    float wA = 0.f, wB = rl, lnew = lse;
    if (!first) { const float la = accL[tl]; const float M = fmaxf(la, lse); const float ea = ex2(la - M), eb = ex2(lse - M); const float sm = ea + eb; lnew = M + lg2(sm); const float inv = rcpf_(sm); wA = ea * inv; wB = eb * inv * rl; }
    if (hi == 0) { wsf[r32] = wA; wsf[32 + r32] = wB; ((LAS int*)wsf)[64 + r32] = tl; if (keep_l) accL[tl] = lnew; }
    LDS_WAIT();
#pragma unroll
    for (int r = 0; r < 16; ++r) {
        const int q = crow(r, hi);
        const float a = wsf[q], b = wsf[32 + q]; const int tq = ((LAS int*)wsf)[64 + q];
        LAS unsigned short* p0 = accO + tq * 64 + r32;
        float n0 = b * st.o0[r], n1 = b * st.o1[r];
        if (!first) { n0 += a * bf1(p0[0]); n1 += a * bf1(p0[32]); }
        p0[0] = (unsigned short)f2bf(n0); p0[32] = (unsigned short)f2bf(n1);
    }
}

__device__ __forceinline__ void attn_unit(Frame& F, const Args& A, int b, int h, int J, BgCopy& bg) {
    LAS unsigned char* base = F.lds + RING_OFF;
    const int lane = F.lane, w = F.wave, r32 = lane & 31, hi = lane >> 5;
    const bf16* P = (const bf16*)(F.ws + WS_P);
    const size_t rowb = (size_t)b * SEQ;
    const bf16* Qh = P + 0 * PREG + rowb * 1024 + h * 64;
    const bf16* Kh = P + 1 * PREG + rowb * 1024 + h * 64;
    const bf16* Vh = P + 2 * PREG + rowb * 1024 + h * 64;
    { const float* TAB = (const float*)(F.ws + WS_TAB) + TAB_BT + h * 396; LAS float* bt = (LAS float*)(base + A_BT);
      for (int i = F.tid; i < 3 * 256 + 64; i += NWAVES * 64) { const int p = i >> 8, u = i & 255, sd = u - 64; bt[i] = (i < 768 && sd >= 0 && sd <= 128) ? TAB[p * 132 + sd] : -INFINITY; } }
    __syncthreads();
    const LAS float* neg = (const LAS float*)(base + A_NEG);
    LAS unsigned char* Vw0 = base + A_KV + w * 8192;
    LAS unsigned char* Qw = Vw0 + 4096;
    const float* cck = A.in[2]; const float* ccv = A.in[3];
    LAS float* wsf = (LAS float*)(base + A_WS) + w * 128;
#pragma unroll 1
    for (int pat = 0; pat < 3; ++pat) {
        Geo g; int qp0, tl;
        if (pat == 0)      { g.dil = 16; g.im = 15; g.hb = 1; g.res = 2 * w;  qp0 = 16 * J;                 tl = 16 * (r32 & 15) + 2 * w + (r32 >> 4); }
        else if (pat == 1) { g.dil = 4;  g.im = 31; g.hb = 0; g.res = w & 3;  qp0 = 64 * J + 32 * (w >> 2); tl = 4 * (32 * (w >> 2) + r32) + (w & 3); }
        else               { g.dil = 1;  g.im = 31; g.hb = 0; g.res = 0;      qp0 = 256 * J + 32 * w;       tl = 32 * w + r32; }
        const LAS float* bt = (const LAS float*)(base + A_BT) + (2 - pat) * 256;
        { const bf16* qrow = Qh + (size_t)tok_of(g, qp0, r32) * 1024 + 8 * hi;
#pragma unroll
          for (int ks = 0; ks < 4; ++ks) { const bf16x8 qv = *(const bf16x8*)(qrow + 16 * ks); *(LAS bf16x8*)(Qw + ks * 1024 + lane * 16) = qv; } }
        WaveState st; st.m = -INFINITY; st.l = 0.f;
#pragma unroll
        for (int r = 0; r < 16; ++r) { st.o0[r] = 0.f; st.o1[r] = 0.f; }
        int kp, kend, kstep, sb;
        if (pat == 0) { kp = 0; kend = 16 * J; kstep = 16; sb = 16 * J; }
        else { kp = qp0 - 128; kend = qp0; kstep = 32; sb = 128; if (kp < 0) { sb += kp; kp = 0; } }
        TileRegs ta, tb; TilePtrs tp;
        tile_ptrs(tp, Kh, Vh, g, lane);
        const long tstr = (long)g.dil * 2048;
        tile_issue(ta, tp, (long)kp * tstr);
#pragma unroll 1
        for (;;) {
            bool more = (kp + kstep <= kend);
            tile_issue(tb, tp, (long)(more ? kp + kstep : kp) * tstr);
#if BG_ON
            bg_step<0>(bg, cck, ccv, F.out, lane);
#endif
            tile_compute(st, Qw, ta, g, sb, Vw0, wsf, bt, neg, lane);
            if (!more) break;
            kp += kstep; sb -= kstep;
            more = (kp + kstep <= kend);
            tile_issue(ta, tp, (long)(more ? kp + kstep : kp) * tstr);
#if BG_ON
            bg_step<1>(bg, cck, ccv, F.out, lane);
#endif
            tile_compute(st, Qw, tb, g, sb, Vw0, wsf, bt, neg, lane);
            if (!more) break;
            kp += kstep; sb -= kstep;
        }
        merge(base, st, tl, pat == 0, pat < 2, w, lane);
        if (pat < 2) __syncthreads();
    }
    LDS_WAIT(); asm volatile("" ::: "memory");
    const int c8 = lane & 7;
    const LAS unsigned char* accO = base + A_ACCO;
    const bf16* GA = P + 3 * PREG; bf16* Y = (bf16*)(F.ws + WS_Y); float* SSQ = (float*)(F.ws + WS_SSQ);
    const float* nw = A.in[9] + h * 64 + 8 * c8;
    const f32x4 nw0 = *(const f32x4*)nw, nw1 = *(const f32x4*)(nw + 4);
#pragma unroll
    for (int i = 0; i < 4; ++i) {
        const int tloc = 32 * w + 8 * i + (lane >> 3);
        const size_t m = rowb + 256 * J + tloc;
        const v4u ov = *(const LAS v4u*)(accO + tloc * 128 + c8 * 16);
        const v4u gv = *(const v4u*)(GA + m * 1024 + h * 64 + 8 * c8);
        float o[8] = {bflo(ov.x), bfhi(ov.x), bflo(ov.y), bfhi(ov.y), bflo(ov.z), bfhi(ov.z), bflo(ov.w), bfhi(ov.w)};
        float gg[8] = {bflo(gv.x), bfhi(gv.x), bflo(gv.y), bfhi(gv.y), bflo(gv.z), bfhi(gv.z), bflo(gv.w), bfhi(gv.w)};
        float ss = 0.f;
#pragma unroll
        for (int k = 0; k < 8; ++k) ss += o[k] * o[k];
        ss += __shfl_xor(ss, 1); ss += __shfl_xor(ss, 2); ss += __shfl_xor(ss, 4);
        if (c8 == 0) SSQ[m * 32 + h] = ss;
        float y[8];
#pragma unroll
        for (int k = 0; k < 8; ++k) y[k] = o[k] * siluf_(gg[k]) * (k < 4 ? nw0[k] : nw1[k - 4]);
        v4u yo; yo.x = pk2(y[0], y[1]); yo.y = pk2(y[2], y[3]); yo.z = pk2(y[4], y[5]); yo.w = pk2(y[6], y[7]);
        *(v4u*)(Y + m * 2048 + h * 64 + 8 * c8) = yo;
    }
    __syncthreads();
}
}


namespace lru {
constexpr int TC = 64;
constexpr int L_XCS = 0;
constexpr int L_AB = 16384;
constexpr int L_HS = 81920;
constexpr int L_CW = 114688;
typedef float f32x2_t __attribute__((ext_vector_type(2)));
__device__ __forceinline__ void unpack8(const v4u a, float (&x)[8]) { x[0] = bflo(a.x); x[1] = bfhi(a.x); x[2] = bflo(a.y); x[3] = bfhi(a.y); x[4] = bflo(a.z); x[5] = bfhi(a.z); x[6] = bflo(a.w); x[7] = bfhi(a.w); }

__device__ __forceinline__ void lru_unit(Frame& F, const Args& A, int cb, int R0, int nrows, int TSEG, bool smp, int bidx0) {
    LAS unsigned char* base = F.lds + RING_OFF;
    const int tid = F.tid, w = F.wave;
    const bf16* P = (const bf16*)(F.ws + WS_P);
    const bf16* XR = P + 4 * PREG + cb * 64; const bf16* GR = P + 5 * PREG + cb * 64;
    bf16* Y = (bf16*)(F.ws + WS_Y) + 1024 + cb * 64; float* SSQ = (float*)(F.ws + WS_SSQ);
    const float* TAB = (const float*)(F.ws + WS_TAB);
    const int ch0 = cb * 64;
    const int nchunk = nrows / TC;
    { LAS float* cl = (LAS float*)(base + L_CW); if (tid < 384) { const int k = tid >> 6, c = tid & 63; cl[tid] = (k < 4) ? A.in[11][k * 1024 + ch0 + c] : (k == 4 ? A.in[12][ch0 + c] : A.in[10][ch0 + c]); } }
    __syncthreads();
#define LRU_BAR() do { asm volatile("s_waitcnt lgkmcnt(0)" ::: "memory"); __builtin_amdgcn_s_barrier(); asm volatile("" ::: "memory"); } while (0)
#define LRU_GLOAD(co, rbase) do { _Pragma("unroll") for (int k = 0; k < 4; ++k) gl[k] = *(const v4u*)(GR + ((size_t)R0 + (co) * TC + (rbase) + (lane >> 3) + 8 * k) * 1024 + c8); } while (0)
#define LRU_OUT(co, rbase) do { const LAS float* hs = (const LAS float*)(base + L_HS + ((co) & 1) * 16384); \
        _Pragma("unroll") for (int k = 0; k < 4; ++k) { const int row = (rbase) + (lane >> 3) + 8 * k; const size_t m = (size_t)R0 + (co) * TC + row; \
            const f32x4 h0 = *(const LAS f32x4*)(hs + row * 64 + c8), h1 = *(const LAS f32x4*)(hs + row * 64 + c8 + 4); \
            float g[8]; unpack8(gl[k], g); const float hv[8] = {h0[0], h0[1], h0[2], h0[3], h1[0], h1[1], h1[2], h1[3]}; float y[8], ss = 0.f; \
            _Pragma("unroll") for (int j = 0; j < 8; ++j) { ss += hv[j] * hv[j]; y[j] = hv[j] * siluf_(g[j]) * cwl[320 + j]; } \
            ss += __shfl_xor(ss, 1); ss += __shfl_xor(ss, 2); ss += __shfl_xor(ss, 4); \
            if ((lane & 7) == 0) SSQ[m * 32 + 16 + cb] = ss; \
            v4u y0; y0.x = pk2(y[0], y[1]); y0.y = pk2(y[2], y[3]); y0.z = pk2(y[4], y[5]); y0.w = pk2(y[6], y[7]); \
            *(v4u*)(Y + m * 2048 + c8) = y0; } } while (0)
    if (w == 0) {
      int ln = F.lane; asm volatile("" : "+v"(ln));
      const int lane = ln, c8 = 8 * (lane & 7);
      const LAS float* cwl = (const LAS float*)(base + L_CW) + c8;
      v4u gl[4];
      LRU_GLOAD(0, 32);
      float hcar = 0.f;
      for (int i = -2; i <= nchunk; ++i) {
        if (i >= 0 && i < nchunk) {
            const LAS f32x2_t* ab = (const LAS f32x2_t*)(base + L_AB + (i & 1) * 32768);
            LAS float* hs = (LAS float*)(base + L_HS + (i & 1) * 16384);
            if (!smp) {
#pragma unroll 16
                for (int r = 0; r < TC; ++r) { const f32x2_t v = ab[r * 64 + lane]; hcar = v.x * hcar + v.y; hs[r * 64 + lane] = hcar; }
                if (i == nchunk - 1) F.out[O_LP + (size_t)bidx0 * 1024 + ch0 + lane] = hcar;
            } else {
                float hin[8];
#pragma unroll
                for (int sg = 0; sg < 8; ++sg) hin[sg] = A.in[5][(size_t)(i * 8 + sg) * 1024 + ch0 + lane];
#pragma unroll
                for (int sg = 0; sg < 8; ++sg) {
                    hcar = hin[sg];
#pragma unroll
                    for (int r8 = 0; r8 < 8; ++r8) { const int r = sg * 8 + r8; const f32x2_t v = ab[r * 64 + lane]; hcar = v.x * hcar + v.y; hs[r * 64 + lane] = hcar; }
                    F.out[O_LS + (size_t)(i * 8 + sg) * 1024 + ch0 + lane] = hcar;
                }
            }
        }
        const int co = i - 1;
        if (co >= 0 && co < nchunk) { LRU_OUT(co, 32); if (co + 1 < nchunk) LRU_GLOAD(co + 1, 32); }
        LRU_BAR();
      }
    } else if (w <= 4) {
      int ln = F.lane; asm volatile("" : "+v"(ln));
      const int lane = ln;
      bf16x8 wb[2][4][2]; float bgx[4], bga[4], la0[4];
      { const bf16* WG = (const bf16*)(F.ws + WS_WG) + (size_t)cb * 2 * 4096;
#pragma unroll
        for (int g = 0; g < 2; ++g)
#pragma unroll
            for (int n = 0; n < 4; ++n)
#pragma unroll
                for (int ks = 0; ks < 2; ++ks) wb[g][n][ks] = *(const bf16x8*)(WG + g * 4096 + (16 * n + (lane & 15)) * 64 + 32 * ks + 8 * (lane >> 4));
#pragma unroll
        for (int n = 0; n < 4; ++n) { const int cg = ch0 + 16 * n + (lane & 15); bgx[n] = A.in[14][cg]; bga[n] = A.in[16][cg]; la0[n] = TAB[TAB_LA0 + cg] * LOG2E; } }
      for (int i = -2; i <= nchunk; ++i) {
        const int c = i + 1;
        if (c >= 0 && c < nchunk) {
            const LAS unsigned char* xs = base + L_XCS + (c & 1) * 8192;
            LAS f32x2_t* ab = (LAS f32x2_t*)(base + L_AB + (c & 1) * 32768);
            const int arow = 16 * (w - 1) + (lane & 15), g4 = lane >> 4, sw = (arow >> 1) & 7;
            bf16x8 af[2];
#pragma unroll
            for (int ks = 0; ks < 2; ++ks) af[ks] = *(const LAS bf16x8*)(xs + arow * 128 + (((4 * ks + g4) ^ sw) << 4));
#pragma unroll
            for (int n = 0; n < 4; ++n) {
                f32x4 ax = {0.f, 0.f, 0.f, 0.f}, aa = {0.f, 0.f, 0.f, 0.f};
#pragma unroll
                for (int ks = 0; ks < 2; ++ks) { ax = __builtin_amdgcn_mfma_f32_16x16x32_bf16(af[ks], wb[0][n][ks], ax, 0, 0, 0); aa = __builtin_amdgcn_mfma_f32_16x16x32_bf16(af[ks], wb[1][n][ks], aa, 0, 0, 0); }
                const int cl = 16 * n + (lane & 15);
#pragma unroll
                for (int rg = 0; rg < 4; ++rg) {
                    const int row = 16 * (w - 1) + 4 * g4 + rg;
                    const float xc = bf1(*(const LAS unsigned short*)(xs + row * 128 + ((((cl >> 3) ^ ((row >> 1) & 7))) << 4) + (cl & 7) * 2));
                    const float gx = sigmoidf_(ax[rg] + bgx[n]), ga = sigmoidf_(aa[rg] + bga[n]);
                    const float a = ex2(ga * la0[n]);
                    const float mult = __builtin_amdgcn_sqrtf(fmaxf(1.f - a * a, 0.f));
                    ab[row * 64 + cl] = (f32x2_t){a, mult * gx * xc};
                }
            }
        }
        LRU_BAR();
      }
    } else if (w <= 6) {
      int t6 = tid - 320; asm volatile("" : "+v"(t6));
      const int q4 = t6 >> 3, c8 = 8 * (t6 & 7);
      const LAS float* cwl = (const LAS float*)(base + L_CW) + c8;
      v4u xl[7];
#define LRU_XLOAD(cc) do { _Pragma("unroll") for (int k = 0; k < 7; ++k) { int rs = (cc) * TC + 4 * q4 - 3 + k; rs = rs < 0 ? 0 : rs; xl[k] = *(const v4u*)(XR + ((size_t)R0 + rs) * 1024 + c8); } } while (0)
      LRU_XLOAD(0);
      for (int i = -2; i <= nchunk; ++i) {
        const int cc = i + 2;
        if (cc < nchunk) {
            LAS unsigned char* xs = base + L_XCS + (cc & 1) * 8192;
            const int rr0 = cc * TC + 4 * q4;
            float xv[7][8];
#pragma unroll
            for (int k = 0; k < 7; ++k) unpack8(xl[k], xv[k]);
            if (cc + 1 < nchunk) LRU_XLOAD(cc + 1);
            if (!smp) { if (rr0 == 0) {
#pragma unroll
                    for (int k = 0; k < 3; ++k)
#pragma unroll
                        for (int j = 0; j < 8; ++j) xv[k][j] = 0.f; } }
            else if ((rr0 & 4) == 0) {
                const float* cp = A.in[4] + (size_t)(rr0 >> 3) * 3 * 1024 + ch0 + c8;
#pragma unroll
                for (int k = 0; k < 3; ++k) { const f32x4 c0 = *(const f32x4*)(cp + k * 1024), c1 = *(const f32x4*)(cp + k * 1024 + 4);
                    xv[k][0] = c0[0]; xv[k][1] = c0[1]; xv[k][2] = c0[2]; xv[k][3] = c0[3]; xv[k][4] = c1[0]; xv[k][5] = c1[1]; xv[k][6] = c1[2]; xv[k][7] = c1[3]; }
            }
#pragma unroll
            for (int r = 0; r < 4; ++r) {
                const int row = 4 * q4 + r, rr = rr0 + r;
                float xc[8];
#pragma unroll
                for (int j = 0; j < 8; ++j) xc[j] = cwl[256 + j] + cwl[j] * xv[r][j] + cwl[64 + j] * xv[r + 1][j] + cwl[128 + j] * xv[r + 2][j] + cwl[192 + j] * xv[r + 3][j];
                const int tin = smp ? (rr & 7) : rr;
                if (tin >= TSEG - 3) { float* co = F.out + (smp ? O_CS : O_CP) + ((size_t)(smp ? (rr >> 3) : bidx0) * 3 + (tin - (TSEG - 3))) * 1024 + ch0 + c8;
                    *(f32x4*)(co) = (f32x4){xv[r + 3][0], xv[r + 3][1], xv[r + 3][2], xv[r + 3][3]}; *(f32x4*)(co + 4) = (f32x4){xv[r + 3][4], xv[r + 3][5], xv[r + 3][6], xv[r + 3][7]}; }
                v4u s0; s0.x = pk2(xc[0], xc[1]); s0.y = pk2(xc[2], xc[3]); s0.z = pk2(xc[4], xc[5]); s0.w = pk2(xc[6], xc[7]);
                *(LAS v4u*)(xs + row * 128 + ((((t6 & 7)) ^ ((row >> 1) & 7)) << 4)) = s0;
            }
        }
        LRU_BAR();
      }
#undef LRU_XLOAD
    } else {
      int ln = F.lane; asm volatile("" : "+v"(ln));
      const int lane = ln, c8 = 8 * (lane & 7);
      const LAS float* cwl = (const LAS float*)(base + L_CW) + c8;
      v4u gl[4];
      LRU_GLOAD(0, 0);
      for (int i = -2; i <= nchunk; ++i) {
        const int co = i - 1;
        if (co >= 0 && co < nchunk) { LRU_OUT(co, 0); if (co + 1 < nchunk) LRU_GLOAD(co + 1, 0); }
        LRU_BAR();
      }
    }
#undef LRU_GLOAD
#undef LRU_OUT
#undef LRU_BAR
}
}

__device__ __forceinline__ void copy_phase(Frame& F, const Args& A, att::BgCopy& bg) {
    const float* ck = A.in[2]; const float* cv = A.in[3];
    const int lane = F.lane;
    att::bg_flush(bg, F.out, lane);
    unsigned i0 = bg.cur;
    for (; i0 + 512u <= bg.end; i0 += 512u) {
        f32x4 v[8];
#pragma unroll
        for (int u = 0; u < 8; ++u) v[u] = __builtin_nontemporal_load(att::bg_src(ck, cv, i0 + (unsigned)lane + 64u * u));
#pragma unroll
        for (int u = 0; u < 8; ++u) __builtin_nontemporal_store(v[u], att::bg_dst(F.out, i0 + (unsigned)lane + 64u * u));
    }
    for (unsigned ix = i0 + (unsigned)lane; ix < bg.end; ix += 64u) { const f32x4 v = __builtin_nontemporal_load(att::bg_src(ck, cv, ix)); __builtin_nontemporal_store(v, att::bg_dst(F.out, ix)); }
    bg.cur = bg.end;
}

namespace smp {
#ifndef SMP_STAMP
#define SMP_STAMP(k) do {} while (0)
#endif
__device__ __forceinline__ void unit(Frame& F, const Args& A, int b, int g) {
    int ln_ = F.lane; asm volatile("" : "+v"(ln_));
    const int t = F.wave, lane = ln_;
    const int m = MP + b * 8 + t;
    const bf16* P = (const bf16*)(F.ws + WS_P);
    const float* TAB = (const float*)(F.ws + WS_TAB) + TAB_BT;
    float* SPO = (float*)(F.ws + WS_SPO); float* SPM = (float*)(F.ws + WS_SPM); float* SPL = SPM + 32 * 8 * 8 * 16;
    float q[4][4];
#pragma unroll
    for (int i = 0; i < 4; ++i) { const v2u qv = *(const v2u*)(P + (size_t)m * 1024 + 256 * i + 4 * lane); q[i][0] = bflo(qv.x); q[i][1] = bfhi(qv.x); q[i][2] = bflo(qv.y); q[i][3] = bfhi(qv.y); }
    float mr[4], l[4], o[4][4];
#pragma unroll
    for (int i = 0; i < 4; ++i) { mr[i] = -INFINITY; l[i] = 0.f; o[i][0] = o[i][1] = o[i][2] = o[i][3] = 0.f; }
    const float* ck = A.in[2] + (size_t)b * 2048 * 1024; const float* cv = A.in[3] + (size_t)b * 2048 * 1024;
    float* nk = F.out + O_KS + (size_t)b * 2048 * 1024; float* nv = F.out + O_VS + (size_t)b * 2048 * 1024;
#define SMP_VISIT(v_) int j_, p_, s_, mult_; bool copy_; { const int vv = (v_); \
        if (vv < 12) { const int k = 12 * g + vv; j_ = 16 * k + t; p_ = 2; s_ = 128 - k; mult_ = 1; copy_ = (j_ >= 8); } \
        else if (vv < 24) { const int i2 = 12 * g + vv - 12; j_ = 1536 + t + 4 * i2; p_ = 1; s_ = 128 - i2; mult_ = ((i2 & 3) == 0) ? 2 : 1; copy_ = ((i2 & 1) == 0); } \
        else { int n = 17 * g + vv - 24; const bool ok = (n <= 128); n = ok ? n : 128; j_ = 1920 + t + n; p_ = 0; s_ = 128 - n; mult_ = ok ? (1 + ((s_ & 3) == 0 ? 1 : 0) + ((s_ & 15) == 0 ? 1 : 0)) : 0; copy_ = ok && ((n & 7) == 0) && (j_ < 2048); } }
#define SMP_LOAD(K4, V4, v_) do { SMP_VISIT(v_) (void)p_; (void)s_; (void)mult_; (void)copy_; \
        const float* kr = (j_ < 2048) ? ck + (size_t)j_ * 1024 : nk + (size_t)(j_ - 8) * 1024; const float* vr = (j_ < 2048) ? cv + (size_t)j_ * 1024 : nv + (size_t)(j_ - 8) * 1024; \
        _Pragma("unroll") for (int i = 0; i < 4; ++i) { K4[i] = *(const f32x4*)(kr + 256 * i + 4 * lane); V4[i] = *(const f32x4*)(vr + 256 * i + 4 * lane); } } while (0)
#define SMP_PROC(K4, V4, v_) do { SMP_VISIT(v_) \
        if (copy_) { f32x4* ko = (f32x4*)(nk + (size_t)(j_ - 8) * 1024) + lane; f32x4* vo = (f32x4*)(nv + (size_t)(j_ - 8) * 1024) + lane; \
          _Pragma("unroll") for (int i = 0; i < 4; ++i) { __builtin_nontemporal_store(K4[i], ko + 64 * i); __builtin_nontemporal_store(V4[i], vo + 64 * i); } } \
        if (mult_ > 0) { const float fm = (float)mult_; \
        _Pragma("unroll") for (int i = 0; i < 4; ++i) { \
            float d = K4[i][0] * q[i][0] + K4[i][1] * q[i][1] + K4[i][2] * q[i][2] + K4[i][3] * q[i][3]; \
            d += __shfl_xor(d, 1); d += __shfl_xor(d, 2); d += __shfl_xor(d, 4); d += __shfl_xor(d, 8); \
            const int hd = 4 * i + (lane >> 4); \
            const float s2 = d + TAB[hd * 396 + p_ * 132 + s_]; \
            const float mn = fmaxf(mr[i], s2), al = ex2(mr[i] - mn), pp = fm * ex2(s2 - mn); \
            l[i] = l[i] * al + pp; mr[i] = mn; \
            _Pragma("unroll") for (int k = 0; k < 4; ++k) o[i][k] = o[i][k] * al + pp * V4[i][k]; } } } while (0)
    {
        f32x4 k0[4], v0[4], k1[4], v1[4], k2[4], v2[4], k3[4], v3[4];
#define SMP_RANGE(va, vb) do { const int ve_ = (vb); \
        SMP_LOAD(k0, v0, (va)); SMP_LOAD(k1, v1, ((va) + 1 < ve_) ? (va) + 1 : ve_ - 1); SMP_LOAD(k2, v2, ((va) + 2 < ve_) ? (va) + 2 : ve_ - 1); \
        _Pragma("unroll 1") for (int v = (va); v < ve_; v += 4) { \
            SMP_LOAD(k3, v3, (v + 3 < ve_) ? v + 3 : ve_ - 1); SMP_PROC(k0, v0, v); \
            SMP_LOAD(k0, v0, (v + 4 < ve_) ? v + 4 : ve_ - 1); if (v + 1 < ve_) SMP_PROC(k1, v1, v + 1); \
            SMP_LOAD(k1, v1, (v + 5 < ve_) ? v + 5 : ve_ - 1); if (v + 2 < ve_) SMP_PROC(k2, v2, v + 2); \
            SMP_LOAD(k2, v2, (v + 6 < ve_) ? v + 6 : ve_ - 1); if (v + 3 < ve_) SMP_PROC(k3, v3, v + 3); } } while (0)
        SMP_STAMP(0);
        SMP_RANGE(0, 12);
        SMP_STAMP(1);
        SMP_RANGE(12, 24);
        SMP_STAMP(2);
        SMP_RANGE(24, 41);
        SMP_STAMP(3);
#undef SMP_RANGE
    }
#undef SMP_VISIT
#undef SMP_LOAD
#undef SMP_PROC
    const size_t pi = ((size_t)(b * 8 + g) * 8 + t);
#pragma unroll
    for (int i = 0; i < 4; ++i) {
        *(f32x4*)(SPO + pi * 1024 + 256 * i + 4 * lane) = (f32x4){o[i][0], o[i][1], o[i][2], o[i][3]};
        if ((lane & 15) == 0) { const int hd = 4 * i + (lane >> 4); SPM[pi * 16 + hd] = mr[i]; SPL[pi * 16 + hd] = l[i]; }
    }
    VM_WAIT(); __syncthreads();
    if (F.tid == 0) {
        __builtin_amdgcn_fence(__ATOMIC_RELEASE, "agent");
        asm volatile("s_waitcnt vmcnt(0)" ::: "memory");
        const unsigned old = __hip_atomic_fetch_add((unsigned*)(F.ctl + CW_SCNT + 64 * b), 1u, __ATOMIC_RELAXED, __HIP_MEMORY_SCOPE_AGENT);
        const unsigned last = (old == 7u) ? 1u : 0u;
        if (last) { __builtin_amdgcn_fence(__ATOMIC_ACQUIRE, "agent"); asm volatile("s_waitcnt vmcnt(0)" ::: "memory"); }
        F.MISC[16] = last;
    }
    __syncthreads();
    const bool last = F.MISC[16] != 0u;
    __syncthreads();
    if (!last) return;
    float M[4], L[4], O[4][4];
#pragma unroll
    for (int i = 0; i < 4; ++i) { M[i] = -INFINITY; L[i] = 0.f; O[i][0] = O[i][1] = O[i][2] = O[i][3] = 0.f; }
    for (int gg = 0; gg < 8; ++gg) { const size_t pj = ((size_t)(b * 8 + gg) * 8 + t);
#pragma unroll
        for (int i = 0; i < 4; ++i) M[i] = fmaxf(M[i], SPM[pj * 16 + 4 * i + (lane >> 4)]); }
    for (int gg = 0; gg < 8; ++gg) { const size_t pj = ((size_t)(b * 8 + gg) * 8 + t);
#pragma unroll
        for (int i = 0; i < 4; ++i) { const int hd = 4 * i + (lane >> 4); const float wgt = ex2(SPM[pj * 16 + hd] - M[i]); L[i] += SPL[pj * 16 + hd] * wgt;
            const f32x4 ov = *(const f32x4*)(SPO + pj * 1024 + 256 * i + 4 * lane);
#pragma unroll
            for (int k = 0; k < 4; ++k) O[i][k] += ov[k] * wgt; } }
    bf16* Y = (bf16*)(F.ws + WS_Y); float* SSQ = (float*)(F.ws + WS_SSQ);
#pragma unroll
    for (int i = 0; i < 4; ++i) {
        const float rl = 1.f / L[i]; float ov[4], ss = 0.f;
#pragma unroll
        for (int k = 0; k < 4; ++k) { ov[k] = O[i][k] * rl; ss += ov[k] * ov[k]; }
        ss += __shfl_xor(ss, 1); ss += __shfl_xor(ss, 2); ss += __shfl_xor(ss, 4); ss += __shfl_xor(ss, 8);
        const int col = 256 * i + 4 * lane;
        if ((lane & 15) == 0) SSQ[(size_t)m * 32 + 4 * i + (lane >> 4)] = ss;
        const v2u gv = *(const v2u*)(P + 3 * PREG + (size_t)m * 1024 + col);
        const f32x4 nw = *(const f32x4*)(A.in[9] + col);
        const float g0 = bflo(gv.x), g1 = bfhi(gv.x), g2 = bflo(gv.y), g3 = bfhi(gv.y);
        v2u yo; yo.x = pk2(ov[0] * siluf_(g0) * nw[0], ov[1] * siluf_(g1) * nw[1]); yo.y = pk2(ov[2] * siluf_(g2) * nw[2], ov[3] * siluf_(g3) * nw[3]);
        *(v2u*)(Y + (size_t)m * 2048 + col) = yo;
    }
}
}


__device__ __forceinline__ void final_norm(Frame& F, const Args& A) {
    const int gw = F.vcu * NWAVES + F.wave, NGW = F.G * NWAVES;
    const GAS f32x4* gf = (const GAS f32x4*)A.in[19] + F.lane;
    for (int m = gw; m < MT; m += NGW) {
        GAS f32x4* zr = (GAS f32x4*)(F.out + (size_t)m * DM) + F.lane;
        f32x4 v[4]; float s = 0.f;
#pragma unroll
        for (int j = 0; j < 4; ++j) { v[j] = zr[64 * j]; s += (v[j].x * v[j].x + v[j].y * v[j].y) + (v[j].z * v[j].z + v[j].w * v[j].w); }
        const float rstd = 1.f / sqrtf(wave_sum(s) * (1.f / DM) + EPS);
#pragma unroll
        for (int j = 0; j < 4; ++j) { const f32x4 g = gf[64 * j]; zr[64 * j] = (f32x4){v[j].x * rstd * g.x, v[j].y * rstd * g.y, v[j].z * rstd * g.z, v[j].w * rstd * g.w}; }
    }
}

__device__ __forceinline__ void sample_outproj(Frame& F, const Args& A) {
    int ln_ = F.lane; asm volatile("" : "+v"(ln_));
    const int lane = ln_, r16 = lane & 15, g4 = lane >> 4, w = F.wave, half = w >> 2;
    const bf16* Y = (const bf16*)(F.ws + WS_Y) + (size_t)MP * 2048; const bf16* W = (const bf16*)(F.ws + WS_WOUT);
    const float* SSQ = (const float*)(F.ws + WS_SSQ) + (size_t)MP * 32;
    LAS float* xch = (LAS float*)(F.lds + RING_OFF) + (w & 3) * 256;
    for (int t0 = F.vcu * 4; t0 < 1024; t0 += F.G * 4) {
        const int t = t0 + (w & 3), tr = t >> 6, tc = t & 63;
        const bf16* ap = Y + (size_t)(16 * tr + r16) * 2048 + 8 * g4 + 1024 * half;
        const bf16* bp = W + (size_t)(16 * tc + r16) * 2048 + 8 * g4 + 1024 * half;
        f32x4 acc = {0.f, 0.f, 0.f, 0.f};
#pragma unroll 1
        for (int k0 = 0; k0 < 32; k0 += 8) {
            bf16x8 af[8], bfm[8];
#pragma unroll
            for (int k = 0; k < 8; ++k) { af[k] = *(const bf16x8*)(ap + 32 * (k0 + k)); bfm[k] = *(const bf16x8*)(bp + 32 * (k0 + k)); }
#pragma unroll
            for (int k = 0; k < 8; ++k) acc = __builtin_amdgcn_mfma_f32_16x16x32_bf16(af[k], bfm[k], acc, 0, 0, 0);
        }
        float rsc;
        { const f32x4* sp = (const f32x4*)(SSQ + (size_t)(16 * tr + r16) * 32 + 16 * half); float sa = 0.f;
#pragma unroll
          for (int k = 0; k < 4; ++k) { const f32x4 a = sp[k]; sa += (a[0] + a[1]) + (a[2] + a[3]); }
          rsc = 1.f / sqrtf(sa * (1.f / 1024.f) + EPS); }
        float v[4];
#pragma unroll
        for (int r = 0; r < 4; ++r) v[r] = __shfl(rsc, 4 * g4 + r) * acc[r];
        if (half == 1) { *(LAS f32x4*)(xch + lane * 4) = (f32x4){v[0], v[1], v[2], v[3]}; }
        __syncthreads();
        if (half == 0) {
            const f32x4 o = *(const LAS f32x4*)(xch + lane * 4);
#pragma unroll
            for (int r = 0; r < 4; ++r) { const size_t idx = (size_t)(16 * tr + 4 * g4 + r) * 1024 + 16 * tc + r16; F.out[O_YS + idx] = A.in[1][idx] + v[r] + o[r]; }
        }
        __syncthreads();
    }
}

__device__ __forceinline__ void copy_range(Frame& F, att::BgCopy& bg) {
    const unsigned per = (att::N4 + (unsigned)F.G - 1u) / (unsigned)F.G, lo = (unsigned)F.vcu * per, hi = (lo + per < att::N4) ? lo + per : att::N4;
    const unsigned pw = (((hi - lo) + 7u) / 8u + 127u) & ~127u;
    unsigned c0 = lo + (unsigned)F.wave * pw, c1 = c0 + pw; if (c0 > hi) c0 = hi; if (c1 > hi) c1 = hi;
    bg.cur = c0; bg.end = c1; bg.pend0 = c1; bg.pend1 = c1; bg.dump = (f32x4*)(F.ws + 420 * MiB) + (size_t)blockIdx.x * 512 + F.tid;
    bg.a0 = bg.a1 = bg.b0 = bg.b1 = (f32x4){0.f, 0.f, 0.f, 0.f};
}

__global__ void __launch_bounds__(NWAVES * 64, 2) fwd_kernel(Args args) {
    extern __shared__ __attribute__((aligned(16))) unsigned char lds[];
    Frame F;
    F.lds = (LAS unsigned char*)lds;
    F.MISC = (volatile LAS unsigned*)(F.lds + MISC_OFF);
    F.tid = threadIdx.x; F.lane = F.tid & 63; F.wave = __builtin_amdgcn_readfirstlane(F.tid >> 6);
    F.G = gridDim.x; { const int bx = blockIdx.x; F.vcu = (F.G % 8 == 0) ? (bx % 8) * (F.G / 8) + bx / 8 : bx; }
    F.out = args.out; F.ws = args.ws;
    F.ctl = (gu32*)(args.ws + WS_CTL);
    for (int u = F.tid; u < (LDS_BYTES - LDSCTL_OFF) / 4; u += NWAVES * 64) ((LAS unsigned*)(F.lds + LDSCTL_OFF))[u] = 0u;
    __syncthreads();
    XcdBarrier bar; bar.bar = (unsigned*)(F.ctl + CW_BAR); bar.x = 0; bar.st = nullptr;
    if (N_LAUNCHES != PER_PHASE) bar = xcd_barrier_post((unsigned*)(F.ctl + CW_BAR), F.MISC + 8);
#define GRID_BAR() do { if (N_LAUNCHES != PER_PHASE) xcd_barrier(bar); } while (0)
    const int lo = args.ph_lo, hi = args.ph_hi;
#ifndef PHASE_MASK
#define PHASE_MASK 0xff
#endif
#define IN(k) (((PHASE_MASK >> (k)) & 1) && lo <= (k) && (k) < hi)
#define BOTH(k) (IN(k) && IN((k) + 1))

    if (IN(0)) { p0_prologue(F, args); if (BOTH(0)) GRID_BAR(); }

    if (IN(1)) {
        pg8::Gemm g{(const pg8::bf16_t*)(F.ws + WS_XN), (const pg8::bf16_t*)(F.ws + WS_WIN), MT, NPROJ, DM};
        pg8::StaticOrder S; S.init(MT, NPROJ, F.G, (int)blockIdx.x);
        pg8::EpiProj E{(pg8::bf16_t*)(F.ws + WS_P), F.out};
        pg8::gemm_phase<pg8::EpiProj, pg8::StaticOrder, PG8_ALIGN, PG8_SP2>(F.lds + RING_OFF, g, S, E);
        if (BOTH(1)) GRID_BAR();
    }

    if (IN(2)) {
#ifndef P2_MASK
#define P2_MASK 15
#endif
        if (P2_MASK & 1) for (int u = F.vcu; u < 144; u += F.G) {
            if (u < 128) lru::lru_unit(F, args, u & 15, (u >> 4) * SEQ, SEQ, SEQ, false, u >> 4);
            else lru::lru_unit(F, args, u - 128, MP, MS, DECT, true, 0);
        }
        att::BgCopy bg; copy_range(F, bg);
        if (P2_MASK & 2) {
            const unsigned myq = xb_xcc_id() & 7u;
            for (unsigned qi = 0; qi < 8u; ++qi) {
                const unsigned q = (myq + qi) & 7u;
                for (;;) {
                    if (F.tid == 0) F.MISC[17] = __hip_atomic_fetch_add((unsigned*)(F.ctl + CW_QA + 64 * q), 1u, __ATOMIC_RELAXED, __HIP_MEMORY_SCOPE_AGENT);
                    __syncthreads();
                    const unsigned idx = F.MISC[17];
                    __syncthreads();
                    if (idx >= 128u) break;
                    const int J = 7 - (int)(idx >> 4), bh = (int)(q * 16u + (idx & 15u));
                    att::attn_unit(F, args, bh >> 4, bh & 15, J, bg);
                }
            }
        }
        if (P2_MASK & 4) for (int u = F.vcu; u < 256; u += F.G) smp::unit(F, args, u >> 3, u & 7);
        if (P2_MASK & 8) copy_phase(F, args, bg);
        if (BOTH(2)) GRID_BAR();
    }

    if (IN(3)) {
        pg8::Gemm g{(const pg8::bf16_t*)(F.ws + WS_Y), (const pg8::bf16_t*)(F.ws + WS_WOUT), MP, DM, DMIX};
        pg8::StaticOrder S; S.init(MP, DM, F.G, (int)blockIdx.x);
        LAS float* rs = (LAS float*)(F.lds + RS_OFF);
        {
            const float* SSQ = (const float*)(F.ws + WS_SSQ);
            pg8::Unit uu;
            for (int i = 0; i < 2; ++i) if (S.next(i, uu)) {
                if (F.tid < 256) { const float* sp = SSQ + ((size_t)uu.pm * 256 + F.tid) * 32; float sa = 0.f, sl = 0.f;
#pragma unroll
                    for (int k = 0; k < 16; ++k) { sa += sp[k]; sl += sp[16 + k]; }
                    const float ra = 1.f / sqrtf(sa * (1.f / 1024.f) + EPS), rl = 1.f / sqrtf(sl * (1.f / 1024.f) + EPS);
                    rs[i * 512 + F.tid * 2] = ra / rl; rs[i * 512 + F.tid * 2 + 1] = rl; }
            }
        }
        __syncthreads();
        pg8::EpiOut E{args.in[0], args.in[1], F.out, (const PG8_LAS float*)rs};
        pg8::gemm_phase<pg8::EpiOut, pg8::StaticOrder, PG8_ALIGN, PG8_SP2>(F.lds + RING_OFF, g, S, E);
        sample_outproj(F, args);
        if (BOTH(3)) GRID_BAR();
    }

    if (IN(4)) { final_norm(F, args); }
#undef IN
#undef BOTH
#undef GRID_BAR
}

extern "C" void kernel_launch(void* const* d_in, const int* in_sizes, int n_in, void* d_out, int out_size, void* d_ws, size_t ws_size, hipStream_t stream) {
    static int grid = 0;
    if (grid == 0) {
        if (n_in != 20 || ws_size < WS_END) { fprintf(stderr, "kernel_launch: unexpected n_in %d / ws %zu\n", n_in, ws_size); grid = -1; return; }
        int dev = 0, cus = 0, per_cu = 0;
        if (hipGetDevice(&dev) != hipSuccess || hipDeviceGetAttribute(&cus, hipDeviceAttributeMultiprocessorCount, dev) != hipSuccess) { grid = -1; return; }
        if (hipFuncSetAttribute((const void*)fwd_kernel, hipFuncAttributeMaxDynamicSharedMemorySize, LDS_BYTES) != hipSuccess) { fprintf(stderr, "kernel_launch: hipFuncSetAttribute failed\n"); grid = -1; return; }
        if (hipOccupancyMaxActiveBlocksPerMultiprocessor(&per_cu, (const void*)fwd_kernel, NWAVES * 64, LDS_BYTES) != hipSuccess || per_cu < 1)
            fprintf(stderr, "kernel_launch: note: occupancy query reports %d workgroups per CU\n", per_cu);
        (void)hipGetLastError();
        grid = cus;
    }
    if (grid < 0) return;
    if (N_LAUNCHES != PER_PHASE) { if (hipMemsetAsync((char*)d_ws + WS_CTL, 0, CTL_ZERO_BYTES, stream) != hipSuccess) return; }
    else { if (hipMemsetAsync((char*)d_ws + WS_CTL, 0, CTL_ZERO_BYTES, stream) != hipSuccess) return; }
    Args a{};
    for (int i = 0; i < 20; ++i) a.in[i] = (const float*)d_in[i];
    a.out = (float*)d_out; a.ws = (unsigned char*)d_ws;
    if (N_LAUNCHES == 1) {
        a.ph_lo = 0; a.ph_hi = PER_PHASE; a.li = 0;
        hipLaunchKernelGGL(fwd_kernel, dim3(grid), dim3(NWAVES * 64), LDS_BYTES, stream, a);
    } else {
        for (int li = 0; li < PER_PHASE; ++li) { a.ph_lo = li; a.ph_hi = li + 1; a.li = li;
            hipLaunchKernelGGL(fwd_kernel, dim3(grid), dim3(NWAVES * 64), LDS_BYTES, stream, a); }
    }
}
```

```cpp
#include <hip/hip_runtime.h>
#include <hip/hip_bf16.h>
#include <cstdio>
#include <cstdint>
#include <cmath>

#ifndef MK_N_LAUNCHES
#define MK_N_LAUNCHES 1
#endif

constexpr int DM = 1024, NBATCH = 8, SEQ = 2048, DECB = 32, DECT = 8, WBK = 2048, NHEAD = 16, HDIM = 64;
constexpr int MP = NBATCH * SEQ;
constexpr int MS = DECB * DECT;
constexpr int MT = MP + MS;
constexpr int NPROJ = 6144, DMIX = 2048;
constexpr float EPS = 1e-6f;
constexpr float LOG2E = 1.4426950408889634f;
constexpr float QSCALE = 0.125f * LOG2E;
constexpr size_t O_YP = 0, O_YS = 16777216, O_KP = 17039360, O_VP = 33816576, O_CP = 50593792, O_LP = 50618368,
                 O_KS = 50626560, O_VS = 117735424, O_CS = 184844288, O_LS = 184942592;
constexpr size_t MiB = 1u << 20;
constexpr size_t WS_CTL = 0, CTL_ZERO_BYTES = 1 * MiB;
constexpr size_t WS_WIN = 2 * MiB;
constexpr size_t WS_WOUT = 14 * MiB;
constexpr size_t WS_WG = 18 * MiB;
constexpr size_t WS_TAB = 19 * MiB;
constexpr size_t WS_XN = 32 * MiB;
constexpr size_t WS_P = 66 * MiB;
constexpr size_t WS_Y = 261 * MiB;
constexpr size_t WS_SSQ = 326 * MiB;
constexpr size_t WS_SPO = 330 * MiB;
constexpr size_t WS_SPM = 339 * MiB;
constexpr size_t WS_END = 341 * MiB;
constexpr size_t PREG = (size_t)MT * 1024;
constexpr int TAB_BT = 0, TAB_LA0 = 16 * 3 * 132;

namespace pg8 {
#define PG8_LAS __attribute__((address_space(3)))
typedef unsigned short bf16_t;
typedef short bf16x8 __attribute__((ext_vector_type(8)));
typedef float f32x4 __attribute__((ext_vector_type(4)));
typedef unsigned u32x4 __attribute__((ext_vector_type(4)));
constexpr int BM = 256, BK = 64, HALF = 128, HTB = HALF * BK * 2  , STAGE_BYTES = 8 * HTB, NXCD = 8, WGM = 8;

__host__ __device__ __forceinline__ int lds_byte(int r, int c) { const int st = (r >> 4) * 2 + (c >> 5), rr = r & 15, cc = c & 31, ob = rr * 64 + cc * 2; return st * 1024 + (ob ^ (((ob >> 9) & 1) << 5)); }
__host__ __device__ __forceinline__ void stage_rc(int b, int& R, int& C) { const int st = b / 1024, sb = b % 1024, swz = sb ^ (((sb >> 9) & 1) << 5); R = (st >> 1) * 16 + swz / 64; C = (st & 1) * 32 + (swz % 64) / 2; }
__host__ __device__ __forceinline__ int perm32(int rho) { const int n = rho >> 4, i = rho & 15; return 8 * (i >> 2) + 4 * n + (i & 3); }

struct Unit { int pm, pn; };
struct Gemm { const bf16_t* A; const bf16_t* Bt; int M, N, K; };

struct StaticOrder {
    int nM, nN, nwg, G, c;
    __host__ __device__ void init(int M, int N, int G_, int c_) { nM = M / BM; nN = N / BM; nwg = nM * nN; G = G_; c = c_; }
    __host__ __device__ bool next(int i, Unit& u) const {
        const long L = (long)i * G + c; if (L >= nwg) return false;
        int wgid = (int)L; { const int q = nwg / NXCD, r = nwg % NXCD, xcd = wgid % NXCD, off = wgid / NXCD; wgid = (xcd < r ? xcd * (q + 1) : r * (q + 1) + (xcd - r) * q) + off; }
        const int nig = WGM * nN, gid = wgid / nig, fm = gid * WGM, gsz = (nM - fm) < WGM ? (nM - fm) : WGM;
        u.pm = fm + ((wgid % nig) % gsz); u.pn = (wgid % nig) / gsz; return true;
    }
    __device__ __forceinline__ void a_ready(const Unit&) const {}
    __device__ __forceinline__ void done(const Unit&) const {}
};

__device__ __forceinline__ unsigned cvt_pk_bf16(float lo, float hi) { unsigned r; asm volatile("v_cvt_pk_bf16_f32 %0, %1, %2" : "=v"(r) : "v"(lo), "v"(hi)); return r; }

struct EpiProj {
    static constexpr bool PERM = true, AFTER_DRAIN = false, MID = false;
    bf16_t* P; float* out;
    __device__ __forceinline__ void mid(f32x4 (&)[2][2][4][2], int, int, int) const {}
    __device__ __forceinline__ void operator()(const f32x4 (&acc)[2][2][4][2], const Unit& u, int ui, int wr, int wc, int fr, int fq) const {
        const int t = u.pn >> 2;
        const int colr = (u.pn & 3) * BM + wc * 32 + 8 * fq;
        const float sc = (t == 0) ? QSCALE : 1.f;
        bf16_t* base = P + (size_t)t * PREG;
        const bool smp = (u.pm == (MP / BM));
        float* fo = nullptr;
        if (t == 1) fo = out + (smp ? O_KS : O_KP); else if (t == 2) fo = out + (smp ? O_VS : O_VP);
        const int row0 = u.pm * BM + wr * 64 + fr;
#pragma unroll
        for (int ai = 0; ai < 2; ++ai)
#pragma unroll
            for (int m = 0; m < 4; ++m) {
                const int row = row0 + ai * HALF + m * 16;
                bf16_t* rowp = base + (size_t)row * 1024 + colr;
                size_t frow = (size_t)row;
                if (smp) { const int sr = row - MP; frow = (size_t)(sr >> 3) * 2048 + 2040 + (sr & 7); }
#pragma unroll
                for (int bj = 0; bj < 2; ++bj) {
                    const f32x4 a0 = acc[ai][bj][m][0], a1 = acc[ai][bj][m][1];
                    u32x4 w; w.x = cvt_pk_bf16(a0[0] * sc, a0[1] * sc); w.y = cvt_pk_bf16(a0[2] * sc, a0[3] * sc); w.z = cvt_pk_bf16(a1[0] * sc, a1[1] * sc); w.w = cvt_pk_bf16(a1[2] * sc, a1[3] * sc);
                    *(u32x4*)(rowp + bj * HALF) = w;
                    if (fo) { float* fp = fo + frow * 1024 + colr + bj * HALF; *(f32x4*)fp = a0; *(f32x4*)(fp + 4) = a1; }
                }
            }
    }
};

struct EpiOut {
    static constexpr bool PERM = false, AFTER_DRAIN = false, MID = true;
    const float* xp; const float* xs; float* out; const PG8_LAS float* rs;
    __device__ __forceinline__ void mid(f32x4 (&acc)[2][2][4][2], int ui, int wr, int fr) const {
        const PG8_LAS float* t = rs + (ui & 1) * 512;
#pragma unroll
        for (int ai = 0; ai < 2; ++ai)
#pragma unroll
            for (int m = 0; m < 4; ++m) { const float f = t[(ai * HALF + wr * 64 + m * 16 + fr) * 2];
#pragma unroll
                for (int bj = 0; bj < 2; ++bj)
#pragma unroll
                    for (int n = 0; n < 2; ++n) acc[ai][bj][m][n] = acc[ai][bj][m][n] * f; }
    }
    __device__ __forceinline__ void operator()(const f32x4 (&acc)[2][2][4][2], const Unit& u, int ui, int wr, int wc, int fr, int fq) const {
        const PG8_LAS float* t = rs + (ui & 1) * 512;
        const bool smp = (u.pm == (MP / BM));
        const int col0 = u.pn * BM + wc * 32 + 4 * fq;
#pragma unroll
        for (int ai = 0; ai < 2; ++ai)
#pragma unroll
            for (int m = 0; m < 4; ++m) {
                const int rl = ai * HALF + wr * 64 + m * 16 + fr, row = u.pm * BM + rl;
                const float f = t[rl * 2 + 1];
                const float* xr = smp ? xs + (size_t)(row - MP) * 1024 : xp + (size_t)row * 1024;
                float* orow = out + (size_t)row * 1024;
#pragma unroll
                for (int bj = 0; bj < 2; ++bj)
#pragma unroll
                    for (int n = 0; n < 2; ++n) { const int c = col0 + bj * HALF + n * 16; const f32x4 xv = *(const f32x4*)(xr + c); *(f32x4*)(orow + c) = xv + acc[ai][bj][m][n] * f; }
            }
    }
};

template <class Epi, class Sched, bool ALIGN_EPI = false, bool SP2 = false>
__device__ __forceinline__ void gemm_phase(PG8_LAS unsigned char* lds, const Gemm g, const Sched& S, const Epi& E) {
    const int tid = threadIdx.x, wid = __builtin_amdgcn_readfirstlane(tid >> 6), lane = tid & 63, wr = wid >> 2, wc = wid & 3, fr = lane & 15, fq = lane >> 4;
    const int K = g.K, nt = K / BK;
    unsigned voffA[2], voffB[2];
#pragma unroll
    for (int i = 0; i < 2; ++i) { int R, C; stage_rc(tid * 16 + i * 8192, R, C); const int Rb = Epi::PERM ? ((R & ~31) + perm32(R & 31)) : R;
        voffA[i] = (unsigned)(R * K + C) * 2u; voffB[i] = (unsigned)(Rb * K + C) * 2u; }
    const size_t kstep = (size_t)(BK * 2);
    const size_t hstep = (size_t)HALF * K * 2;
    const size_t tstep = 2 * hstep;
    const unsigned ldsw = (unsigned)wid * 1024u;
    const int aoff = lds_byte(wr * 64 + fr, fq * 8), boff = lds_byte(wc * 32 + fr, fq * 8);
#define PG8_SA(b, h) (((b) * 2 + (h)) * HTB)
#define PG8_SB(b, h) ((4 + (b) * 2 + (h)) * HTB)
#define PG8_STAGE(bufoff, gbase, voff) do { _Pragma("unroll") for (int _i = 0; _i < 2; ++_i) \
        __builtin_amdgcn_global_load_lds((const unsigned*)((const char*)(gbase) + (voff)[_i]), (PG8_LAS unsigned*)(lds + (bufoff) + ldsw + _i * 8192), 16, 0, 0); } while (0)
#define PG8_LDA(dst, b, h) do { _Pragma("unroll") for (int m = 0; m < 4; ++m) _Pragma("unroll") for (int k = 0; k < 2; ++k) dst[m][k] = *(const PG8_LAS bf16x8*)(lds + PG8_SA(b, h) + aoff + m * 2048 + k * 1024); } while (0)
#define PG8_LDB(dst, b, h) do { _Pragma("unroll") for (int n = 0; n < 2; ++n) _Pragma("unroll") for (int k = 0; k < 2; ++k) dst[n][k] = *(const PG8_LAS bf16x8*)(lds + PG8_SB(b, h) + boff + n * 2048 + k * 1024); } while (0)
#define PG8_MMA(ai, bj, At, Bt) do { __builtin_amdgcn_s_setprio(1); _Pragma("unroll") for (int m = 0; m < 4; ++m) _Pragma("unroll") for (int n = 0; n < 2; ++n) _Pragma("unroll") for (int k = 0; k < 2; ++k) \
        acc[ai][bj][m][n] = __builtin_amdgcn_mfma_f32_16x16x32_bf16(Bt[n][k], At[m][k], acc[ai][bj][m][n], 0, 0, 0); __builtin_amdgcn_s_setprio(0); } while (0)
#define PG8_WAIT_V(n) asm volatile("s_waitcnt vmcnt(" #n ")" ::: "memory")
#define PG8_WAIT_L(n) asm volatile("s_waitcnt lgkmcnt(" #n ")" ::: "memory")
#define PG8_BAR __builtin_amdgcn_s_barrier()
#define PG8_SCHED __builtin_amdgcn_sched_barrier(0)
    Unit cur, nxt; int ui = 0;
    if (!S.next(0, cur)) return;
    f32x4 acc[2][2][4][2];
#pragma unroll
    for (int a = 0; a < 2; ++a)
#pragma unroll
        for (int b = 0; b < 2; ++b)
#pragma unroll
            for (int m = 0; m < 4; ++m)
#pragma unroll
                for (int n = 0; n < 2; ++n) acc[a][b][m][n] = (f32x4){0.f, 0.f, 0.f, 0.f};
    bf16x8 At[4][2], B0[2][2], B1[2][2];
    const char* cA = (const char*)g.A + (size_t)cur.pm * tstep; const char* cB = (const char*)g.Bt + (size_t)cur.pn * tstep;
    S.a_ready(cur);
    if constexpr (SP2) {
        PG8_STAGE(PG8_SB(0, 0), cB, voffB); PG8_STAGE(PG8_SB(0, 1), cB + hstep, voffB); PG8_STAGE(PG8_SA(0, 0), cA, voffA); PG8_STAGE(PG8_SA(0, 1), cA + hstep, voffA);
        if (wr == 1) PG8_BAR;
        PG8_WAIT_V(2); PG8_BAR;
        PG8_STAGE(PG8_SB(1, 0), cB + kstep, voffB); PG8_STAGE(PG8_SA(1, 0), cA + kstep, voffA); PG8_STAGE(PG8_SB(1, 1), cB + hstep + kstep, voffB);
        PG8_WAIT_V(6); PG8_BAR;
    } else {
        PG8_STAGE(PG8_SB(0, 0), cB, voffB); PG8_STAGE(PG8_SA(0, 0), cA, voffA); PG8_STAGE(PG8_SB(0, 1), cB + hstep, voffB); PG8_STAGE(PG8_SA(0, 1), cA + hstep, voffA);
        if (wr == 1) PG8_BAR;
        PG8_WAIT_V(4); PG8_BAR;
        PG8_STAGE(PG8_SB(1, 0), cB + kstep, voffB); PG8_STAGE(PG8_SA(1, 0), cA + kstep, voffA); PG8_STAGE(PG8_SB(1, 1), cB + hstep + kstep, voffB);
        PG8_WAIT_V(6); PG8_BAR;
    }
    for (;;) {
        const bool has_next = S.next(ui + 1, nxt);
        const char* nA = has_next ? (const char*)g.A + (size_t)nxt.pm * tstep : cA; const char* nB = has_next ? (const char*)g.Bt + (size_t)nxt.pn * tstep : cB;
        for (int t = 0; t < nt; t += 2) {
            if constexpr (Epi::MID) { if (t == (nt >> 1)) E.mid(acc, ui, wr, fr); }
            const bool last = (t == nt - 2);
            const char* a1 = cA + (size_t)(t + 1) * kstep;
            const char* a2 = last ? nA : cA + (size_t)(t + 2) * kstep; const char* b2 = last ? nB : cB + (size_t)(t + 2) * kstep;
            const char* a3 = a2 + kstep; const char* b3 = b2 + kstep;
            if (last && has_next) S.a_ready(nxt);
            if constexpr (SP2) {
            PG8_LDB(B0, 0, 0); PG8_LDB(B1, 0, 1); PG8_SCHED; PG8_LDA(At, 0, 0); PG8_STAGE(PG8_SA(1, 1), a1 + hstep, voffA);
            PG8_WAIT_V(8); PG8_WAIT_L(0); PG8_BAR; PG8_MMA(0, 0, At, B0); PG8_MMA(0, 1, At, B1); PG8_BAR; PG8_SCHED;
            PG8_LDA(At, 0, 1); PG8_STAGE(PG8_SB(0, 0), b2, voffB); PG8_STAGE(PG8_SB(0, 1), b2 + hstep, voffB); PG8_STAGE(PG8_SA(0, 0), a2, voffA);
            PG8_WAIT_V(8); PG8_WAIT_L(0); PG8_BAR; PG8_MMA(1, 0, At, B0); PG8_MMA(1, 1, At, B1); PG8_BAR; PG8_SCHED;
            PG8_LDB(B0, 1, 0); PG8_LDB(B1, 1, 1); PG8_SCHED; PG8_LDA(At, 1, 0); PG8_STAGE(PG8_SA(0, 1), a2 + hstep, voffA);
            PG8_WAIT_V(8); PG8_WAIT_L(0); PG8_BAR; PG8_MMA(0, 0, At, B0); PG8_MMA(0, 1, At, B1); PG8_BAR; PG8_SCHED;
            PG8_LDA(At, 1, 1); PG8_STAGE(PG8_SB(1, 0), b3, voffB); PG8_STAGE(PG8_SB(1, 1), b3 + hstep, voffB); PG8_STAGE(PG8_SA(1, 0), a3, voffA);
            PG8_WAIT_V(8); PG8_WAIT_L(0); PG8_BAR; PG8_MMA(1, 0, At, B0); PG8_MMA(1, 1, At, B1); PG8_BAR; PG8_SCHED;
            } else {
            PG8_LDB(B0, 0, 0); PG8_SCHED; PG8_LDA(At, 0, 0); PG8_STAGE(PG8_SA(1, 1), a1 + hstep, voffA);
            PG8_WAIT_L(8); PG8_BAR; PG8_WAIT_L(0); PG8_MMA(0, 0, At, B0); PG8_BAR; PG8_SCHED;
            PG8_LDB(B1, 0, 1); PG8_STAGE(PG8_SB(0, 0), b2, voffB);
            PG8_BAR; PG8_WAIT_L(0); PG8_MMA(0, 1, At, B1); PG8_BAR;
            PG8_LDA(At, 0, 1); PG8_STAGE(PG8_SA(0, 0), a2, voffA);
            PG8_BAR; PG8_WAIT_L(0); PG8_MMA(1, 0, At, B0); PG8_BAR; PG8_SCHED;
            PG8_STAGE(PG8_SB(0, 1), b2 + hstep, voffB);
            PG8_WAIT_V(6); PG8_BAR; PG8_MMA(1, 1, At, B1); PG8_BAR;
            PG8_LDB(B0, 1, 0); PG8_SCHED; PG8_LDA(At, 1, 0); PG8_STAGE(PG8_SA(0, 1), a2 + hstep, voffA);
            PG8_WAIT_L(8); PG8_BAR; PG8_WAIT_L(0); PG8_MMA(0, 0, At, B0); PG8_BAR; PG8_SCHED;
            PG8_LDB(B1, 1, 1); PG8_STAGE(PG8_SB(1, 0), b3, voffB);
            PG8_BAR; PG8_WAIT_L(0); PG8_MMA(0, 1, At, B1); PG8_BAR;
            PG8_LDA(At, 1, 1); PG8_STAGE(PG8_SA(1, 0), a3, voffA);
            PG8_BAR; PG8_WAIT_L(0); PG8_MMA(1, 0, At, B0); PG8_BAR; PG8_SCHED;
            PG8_STAGE(PG8_SB(1, 1), b3 + hstep, voffB);
            PG8_WAIT_V(6); PG8_BAR; PG8_MMA(1, 1, At, B1); PG8_BAR;
            }
        }
        if constexpr (ALIGN_EPI) { if (wr == 0) PG8_BAR; }
        if constexpr (!Epi::AFTER_DRAIN) { E(acc, cur, ui, wr, wc, fr, fq); S.done(cur); }
        if (!has_next) break;
#pragma unroll
        for (int a = 0; a < 2; ++a)
#pragma unroll
            for (int b = 0; b < 2; ++b)
#pragma unroll
                for (int m = 0; m < 4; ++m)
#pragma unroll
                    for (int n = 0; n < 2; ++n) acc[a][b][m][n] = (f32x4){0.f, 0.f, 0.f, 0.f};
        cur = nxt; cA = nA; cB = nB; ++ui;
        if constexpr (ALIGN_EPI) { if (wr == 1) PG8_BAR; }
    }
    PG8_WAIT_V(0);
    if constexpr (!ALIGN_EPI) { if (wr == 0) PG8_BAR; }
    PG8_BAR;
    if constexpr (Epi::AFTER_DRAIN) { E.fused(acc, cur, wr, wc, fr, fq, lds, wid, lane); S.done(cur); }
#undef PG8_SA
#undef PG8_SB
#undef PG8_STAGE
#undef PG8_LDA
#undef PG8_LDB
#undef PG8_MMA
#undef PG8_WAIT_V
#undef PG8_WAIT_L
#undef PG8_BAR
#undef PG8_SCHED
}
}

#ifndef PG8_SP2
#define PG8_SP2 true
#endif
#ifndef PG8_ALIGN
#define PG8_ALIGN true
#endif

constexpr int NWAVES = 8;
constexpr int N_LAUNCHES = MK_N_LAUNCHES;
constexpr int PER_PHASE = 5;
constexpr int CW_TMO = 0, CW_CODE = 1;
constexpr int CW_BAR = 4096;
constexpr int CW_QA = 8192;
constexpr int CW_SCNT = 16384;
constexpr int RING_OFF = 0, RING_BYTES = 131072;
constexpr int LDSCTL_OFF = RING_BYTES, MISC_OFF = LDSCTL_OFF + 320;
constexpr int RS_OFF = RING_BYTES + 1024;
constexpr int LDS_BYTES = 147456;

#define GAS __attribute__((address_space(1)))
#define LAS __attribute__((address_space(3)))
typedef unsigned short bf16;
typedef unsigned v4u __attribute__((ext_vector_type(4)));
typedef unsigned v2u __attribute__((ext_vector_type(2)));
typedef float f32x4 __attribute__((ext_vector_type(4)));
typedef float f32x16 __attribute__((ext_vector_type(16)));
typedef short bf16x8 __attribute__((ext_vector_type(8)));
typedef short s16x4 __attribute__((ext_vector_type(4)));
typedef GAS unsigned gu32;
typedef GAS unsigned long long gu64;
#define RLX_AGENT __ATOMIC_RELAXED, __HIP_MEMORY_SCOPE_AGENT
#define LDS_WAIT() asm volatile("s_waitcnt lgkmcnt(0)" ::: "memory")
#define VM_WAIT() asm volatile("s_waitcnt vmcnt(0)" ::: "memory")
__device__ __forceinline__ unsigned f2bf(float f) { unsigned u = __builtin_bit_cast(unsigned, f); return (u + 0x7fffu + ((u >> 16) & 1u)) >> 16; }
__device__ __forceinline__ unsigned pk2(float lo, float hi) { return f2bf(lo) | (f2bf(hi) << 16); }
__device__ __forceinline__ float bflo(unsigned w) { return __builtin_bit_cast(float, w << 16); }
__device__ __forceinline__ float bfhi(unsigned w) { return __builtin_bit_cast(float, w & 0xffff0000u); }
__device__ __forceinline__ float bf1(unsigned short h) { return __builtin_bit_cast(float, (unsigned)h << 16); }
__device__ __forceinline__ float ex2(float x) { return __builtin_amdgcn_exp2f(x); }
__device__ __forceinline__ float lg2(float x) { return __builtin_amdgcn_logf(x); }
__device__ __forceinline__ float rcpf_(float x) { return __builtin_amdgcn_rcpf(x); }
__device__ __forceinline__ float sigmoidf_(float x) { return rcpf_(1.f + ex2(-x * LOG2E)); }
__device__ __forceinline__ float siluf_(float x) { return x * sigmoidf_(x); }

#define XB_TMO      128
#define XB_XCNT(j)  (256  + 64 * (j))
#define XB_XSUB(j)  (1280 + 64 * (j))
#define XB_XGEN(j)  (2304 + 64 * (j))
#define XB_TOP      3328
#define XB_TOPGEN   3392
#define XCD_BAR_WORDS 3456
#define XB_SPIN_CAP (1u << 18)

__device__ __forceinline__ unsigned xb_ld(unsigned* p)              { return __hip_atomic_load(p, __ATOMIC_RELAXED, __HIP_MEMORY_SCOPE_AGENT); }
__device__ __forceinline__ unsigned xb_add(unsigned* p, unsigned v) { return __hip_atomic_fetch_add(p, v, __ATOMIC_RELAXED, __HIP_MEMORY_SCOPE_AGENT); }
__device__ __forceinline__ unsigned xb_xcc_id() { return (unsigned)__builtin_amdgcn_s_getreg((3 << 11) | 20) & 0xFu; }
#define XB_SPIN(cond, bar) do { unsigned _sp = 0; while (cond) { __builtin_amdgcn_s_sleep(1); \
    if ((++_sp & 255u) == 0u) { if (xb_ld(&(bar)[XB_TMO])) break; if (_sp > XB_SPIN_CAP) { atomicAdd(&(bar)[XB_TMO], 1u); break; } } } } while (0)

struct XcdBarrier {
    unsigned* bar; unsigned x;
    volatile LAS unsigned* st;
};

__device__ __forceinline__ XcdBarrier xcd_barrier_post(unsigned* bar, volatile LAS unsigned* st) {
    XcdBarrier b; b.bar = bar; b.x = xb_xcc_id(); b.st = st;
    if (threadIdx.x == 0) (void)xb_add(&bar[XB_XCNT(b.x)], 1u);
    return b;
}
__device__ __forceinline__ void xcd_barrier_complete(unsigned* bar, unsigned x, unsigned& nloc, unsigned& nx) {
    const unsigned G = gridDim.x * gridDim.y * gridDim.z;
    unsigned sum, cnt, mine, sp = 0u;
    for (;;) {
        sum = 0u; cnt = 0u; mine = 0u;
#pragma unroll
        for (unsigned j = 0; j < 16; ++j) { const unsigned c = xb_ld(&bar[XB_XCNT(j)]); sum += c; cnt += (c > 0u) ? 1u : 0u; mine = (j == x) ? c : mine; }
        if (sum == G) break;
        __builtin_amdgcn_s_sleep(1);
        if ((++sp & 255u) == 0u) { if (xb_ld(&bar[XB_TMO])) break; if (sp > XB_SPIN_CAP) { atomicAdd(&bar[XB_TMO], 1u); break; } }
    }
    nloc = mine > 0u ? mine : 1u; nx = cnt > 0u ? cnt : 1u;
}

__device__ __forceinline__ void xcd_barrier(const XcdBarrier& b) {
    asm volatile("s_waitcnt vmcnt(0)" ::: "memory");
    __syncthreads();
    if (threadIdx.x == 0) {
        unsigned* bar = b.bar;
        __builtin_amdgcn_s_waitcnt(0);
        unsigned nloc = b.st[0], nx = b.st[1];
        if (nloc == 0u) { xcd_barrier_complete(bar, b.x, nloc, nx); b.st[0] = nloc; b.st[1] = nx; }
        const unsigned old = xb_add(&bar[XB_XSUB(b.x)], 1u);
        const unsigned gen = old / nloc;
        if (old + 1u == (gen + 1u) * nloc) {
            __builtin_amdgcn_fence(__ATOMIC_RELEASE, "agent");
            asm volatile("s_waitcnt vmcnt(0)" ::: "memory");
            const unsigned og = xb_add(&bar[XB_TOP], 1u);
            const unsigned tg = og / nx;
            if (og + 1u == (tg + 1u) * nx) xb_add(&bar[XB_TOPGEN], 1u);
            else XB_SPIN(xb_ld(&bar[XB_TOPGEN]) == tg, bar);
            __builtin_amdgcn_fence(__ATOMIC_ACQUIRE, "agent");
            xb_add(&bar[XB_XGEN(b.x)], 1u);
            asm volatile("s_waitcnt vmcnt(0)" ::: "memory");
        } else {
            XB_SPIN(xb_ld(&bar[XB_XGEN(b.x)]) == gen, bar);
            __builtin_amdgcn_fence(__ATOMIC_ACQUIRE, "agent");
            asm volatile("s_waitcnt vmcnt(0)" ::: "memory");
        }
    }
    __syncthreads();
}

struct Args { const float* in[20]; float* out; unsigned char* ws; int ph_lo, ph_hi, li, pad; };
struct Frame {
    LAS unsigned char* lds;
    volatile LAS unsigned* MISC;
    gu32* ctl;
    int tid, lane, wave;
    int vcu, G;
    float* out;
    unsigned char* ws;
};
__device__ __forceinline__ float wave_sum(float v) {
#pragma unroll
    for (int o = 1; o < 64; o <<= 1) v += __shfl_xor(v, o);
    return v;
}

__device__ __forceinline__ void p0_transpose_item(const float* W, int K, int N, bf16* WT, LAS float* scr, int item, int lane) {
    const int nblk = N / 32, kb = item / nblk, nb = item % nblk, k0 = 64 * kb, n0 = 32 * nb;
    f32x4 v[8];
#pragma unroll
    for (int i = 0; i < 8; ++i) v[i] = *(const f32x4*)(W + (size_t)(k0 + (lane >> 3) + 8 * i) * N + n0 + 4 * (lane & 7));
#pragma unroll
    for (int i = 0; i < 8; ++i) { LAS float* d = scr + ((lane >> 3) + 8 * i) * 33 + 4 * (lane & 7); d[0] = v[i][0]; d[1] = v[i][1]; d[2] = v[i][2]; d[3] = v[i][3]; }
    LDS_WAIT(); asm volatile("" ::: "memory");
    const int c = lane & 7;
#pragma unroll
    for (int j = 0; j < 4; ++j) { const int n = (lane >> 3) + 8 * j; const LAS float* s = scr + (8 * c) * 33 + n;
        v4u o; o.x = pk2(s[0 * 33], s[1 * 33]); o.y = pk2(s[2 * 33], s[3 * 33]); o.z = pk2(s[4 * 33], s[5 * 33]); o.w = pk2(s[6 * 33], s[7 * 33]);
        *(GAS v4u*)(WT + (size_t)(n0 + n) * K + k0 + 8 * c) = o; }
    LDS_WAIT(); asm volatile("" ::: "memory");
}
__device__ __forceinline__ int t5_bucket(int d) {
    if (d < 16) return d;
    int b = 15;
    const int thr[16] = {16, 22, 30, 40, 54, 73, 99, 134, 182, 246, 332, 450, 609, 825, 1117, 1513};
#pragma unroll
    for (int i = 0; i < 16; ++i) b += (d >= thr[i]) ? 1 : 0;
    return b;
}
__device__ __forceinline__ void p0_prologue(Frame& F, const Args& A) {
    LAS float* scr = (LAS float*)(F.lds + RING_OFF + F.wave * 16384);
    const int gw = F.vcu * NWAVES + F.wave, NGW = F.G * NWAVES;
    constexpr int I_IN = (DM / 64) * (NPROJ / 32), I_OUT = (DMIX / 64) * (DM / 32), I_G = 16 * 2;
    constexpr int NITEMS = I_IN + I_OUT + 2 * I_G;
    bf16* WIN = (bf16*)(F.ws + WS_WIN); bf16* WOUT = (bf16*)(F.ws + WS_WOUT); bf16* WG = (bf16*)(F.ws + WS_WG);
    for (int it = gw; it < NITEMS; it += NGW) {
        int r = it;
        if (r < I_IN) { p0_transpose_item(A.in[8], DM, NPROJ, WIN, scr, r, F.lane); continue; } r -= I_IN;
        if (r < I_OUT) { p0_transpose_item(A.in[18], DMIX, DM, WOUT, scr, r, F.lane); continue; } r -= I_OUT;
        if (r < I_G) { const int blk = r >> 1; p0_transpose_item(A.in[13] + blk * 4096, 64, 64, WG + (blk * 2 + 0) * 4096, scr, r & 1, F.lane); continue; } r -= I_G;
        { const int blk = r >> 1; p0_transpose_item(A.in[15] + blk * 4096, 64, 64, WG + (blk * 2 + 1) * 4096, scr, r & 1, F.lane); }
    }
    bf16* XN = (bf16*)(F.ws + WS_XN);
    const GAS f32x4* gin = (const GAS f32x4*)A.in[7] + F.lane;
    for (int m0 = gw; m0 < MT; m0 += 2 * NGW) {
        const int m1 = (m0 + NGW < MT) ? m0 + NGW : m0;
        const float* xr0 = (m0 < MP) ? A.in[0] + (size_t)m0 * DM : A.in[1] + (size_t)(m0 - MP) * DM;
        const float* xr1 = (m1 < MP) ? A.in[0] + (size_t)m1 * DM : A.in[1] + (size_t)(m1 - MP) * DM;
        f32x4 v[8]; float s0 = 0.f, s1 = 0.f;
#pragma unroll
        for (int j = 0; j < 4; ++j) { v[j] = ((const GAS f32x4*)xr0)[F.lane + 64 * j]; v[4 + j] = ((const GAS f32x4*)xr1)[F.lane + 64 * j]; }
#pragma unroll
        for (int j = 0; j < 4; ++j) { s0 += (v[j].x * v[j].x + v[j].y * v[j].y) + (v[j].z * v[j].z + v[j].w * v[j].w); s1 += (v[4 + j].x * v[4 + j].x + v[4 + j].y * v[4 + j].y) + (v[4 + j].z * v[4 + j].z + v[4 + j].w * v[4 + j].w); }
        const float r0 = 1.f / sqrtf(wave_sum(s0) * (1.f / DM) + EPS), r1 = 1.f / sqrtf(wave_sum(s1) * (1.f / DM) + EPS);
        GAS unsigned long long* o0 = (GAS unsigned long long*)(XN + (size_t)m0 * DM) + F.lane;
        GAS unsigned long long* o1 = (GAS unsigned long long*)(XN + (size_t)m1 * DM) + F.lane;
#pragma unroll
        for (int j = 0; j < 4; ++j) { const f32x4 g = gin[64 * j];
            o0[64 * j] = (unsigned long long)pk2(v[j].x * r0 * g.x, v[j].y * r0 * g.y) | ((unsigned long long)pk2(v[j].z * r0 * g.z, v[j].w * r0 * g.w) << 32);
            o1[64 * j] = (unsigned long long)pk2(v[4 + j].x * r1 * g.x, v[4 + j].y * r1 * g.y) | ((unsigned long long)pk2(v[4 + j].z * r1 * g.z, v[4 + j].w * r1 * g.w) << 32); }
    }
    float* TAB = (float*)(F.ws + WS_TAB);
    const int gt = F.vcu * (NWAVES * 64) + F.tid, NGT = F.G * NWAVES * 64;
    for (int i = gt; i < 16 * 3 * 132; i += NGT) {
        const int h = i / 396, rem = i % 396, p = rem / 132, s = rem % 132;
        const int sc = s > 128 ? 128 : s;
        TAB[TAB_BT + i] = A.in[6][t5_bucket(sc << (2 * p)) * 16 + h] * LOG2E;
    }
    for (int i = gt; i < 1024; i += NGT) {
        const float x = -A.in[17][i];
        TAB[TAB_LA0 + i] = -8.f * (fmaxf(x, 0.f) + log1pf(expf(-fabsf(x))));
    }
}


#ifndef BG_ON
#define BG_ON 0
#endif
namespace att {
constexpr int A_ACCO = 0;
constexpr int A_ACCL = 32768;
constexpr int A_BT = 33792;
constexpr int A_NEG = A_BT + 3 * 1024;
constexpr int A_WS = 37376;
constexpr int A_KV = 41472;
constexpr int A_END = A_KV + 8 * 8192;
constexpr float THR = 8.0f;
__device__ __forceinline__ int crow(int r, int hi) { return (r & 3) + 8 * (r >> 2) + 4 * hi; }
typedef short v4i16_t __attribute__((ext_vector_type(4)));
__device__ __forceinline__ s16x4 vtr(const LAS unsigned char* p) { return __builtin_bit_cast(s16x4, __builtin_amdgcn_ds_read_tr16_b64_v4i16((LAS v4i16_t*)p)); }
typedef float f32x2_t __attribute__((ext_vector_type(2))); typedef __bf16 bf16x2_t __attribute__((ext_vector_type(2)));
__device__ __forceinline__ unsigned cvtpk(float lo, float hi) { f32x2_t v = {lo, hi}; bf16x2_t b = __builtin_convertvector(v, bf16x2_t); return __builtin_bit_cast(unsigned, b); }

struct Geo { int dil, im, hb, res; };
__device__ __forceinline__ int tok_of(const Geo& g, int p0, int i) { return g.dil * (p0 + (i & g.im)) + g.res + ((i >> 4) & g.hb); }

struct WaveState { f32x16 o0, o1; float m, l; };

constexpr unsigned GRP4 = 2048u, N4 = 64u * 96u * GRP4;
struct BgCopy { unsigned cur, end; unsigned pend0, pend1; f32x4 a0, a1, b0, b1; f32x4* dump; };
__device__ __forceinline__ const f32x4* bg_src(const float* ck, const float* cv, unsigned ix) { const unsigned g = ix / GRP4, off = ix - g * GRP4, zb = g / 96u, k = g - zb * 96u; return (const f32x4*)(((zb >> 5) ? cv : ck) + ((size_t)(zb & 31u) * 2048 + 16 * k + 8) * 1024) + off; }
__device__ __forceinline__ f32x4* bg_dst(float* out, unsigned ix) { const unsigned g = ix / GRP4, off = ix - g * GRP4, zb = g / 96u, k = g - zb * 96u; return (f32x4*)(out + ((zb >> 5) ? O_VS : O_KS) + ((size_t)(zb & 31u) * 2048 + 16 * k) * 1024) + off; }
template <int SET> __device__ __forceinline__ void bg_step(BgCopy& c, const float* ck, const float* cv, float* out, int lane) {
    const unsigned pend = (unsigned)__builtin_amdgcn_readfirstlane((int)(SET == 0 ? c.pend0 : c.pend1));
    const unsigned cur = (unsigned)__builtin_amdgcn_readfirstlane((int)c.cur), end = (unsigned)__builtin_amdgcn_readfirstlane((int)c.end);
    f32x4* sp = (pend < end) ? bg_dst(out, pend) + lane : c.dump;
    const unsigned ld = (cur < end) ? cur : (end >= 128u ? end - 128u : 0u);
    const f32x4* lp = bg_src(ck, cv, ld) + lane;
    if (SET == 0) { __builtin_nontemporal_store(c.a0, sp); __builtin_nontemporal_store(c.a1, sp + 64); c.a0 = __builtin_nontemporal_load(lp); c.a1 = __builtin_nontemporal_load(lp + 64); c.pend0 = (cur < end) ? cur : end; }
    else          { __builtin_nontemporal_store(c.b0, sp); __builtin_nontemporal_store(c.b1, sp + 64); c.b0 = __builtin_nontemporal_load(lp); c.b1 = __builtin_nontemporal_load(lp + 64); c.pend1 = (cur < end) ? cur : end; }
    c.cur = (cur < end) ? cur + 128u : end;
}
__device__ __forceinline__ void bg_flush(BgCopy& c, float* out, int lane) {
    if (c.pend0 < c.end) { f32x4* sp = bg_dst(out, c.pend0) + lane; __builtin_nontemporal_store(c.a0, sp); __builtin_nontemporal_store(c.a1, sp + 64); c.pend0 = c.end; }
    if (c.pend1 < c.end) { f32x4* sp = bg_dst(out, c.pend1) + lane; __builtin_nontemporal_store(c.b0, sp); __builtin_nontemporal_store(c.b1, sp + 64); c.pend1 = c.end; }
}

struct TileRegs { bf16x8 k[4]; v4u v[4]; };
struct TilePtrs { const char* k; const char* v[4]; };
__device__ __forceinline__ void tile_ptrs(TilePtrs& tp, const bf16* Kh, const bf16* Vh, const Geo& g, int lane) {
    const int r32 = lane & 31, hi = lane >> 5;
    tp.k = (const char*)(Kh + (size_t)tok_of(g, 0, r32) * 1024 + 8 * hi);
#pragma unroll
    for (int i = 0; i < 4; ++i) { const int row = 8 * i + (lane >> 3), cp = lane & 7; const int cv = cp ^ (((row >> 1) & 1) << 2); tp.v[i] = (const char*)(Vh + (size_t)tok_of(g, 0, row) * 1024 + cv * 8); }
}
__device__ __forceinline__ void tile_issue(TileRegs& t, const TilePtrs& tp, long boff) {
#pragma unroll
    for (int ks = 0; ks < 4; ++ks) t.k[ks] = *(const bf16x8*)(tp.k + boff + 32 * ks);
#pragma unroll
    for (int i = 0; i < 4; ++i) t.v[i] = *(const v4u*)(tp.v[i] + boff);
}

__device__ __forceinline__ void tile_compute(WaveState& st, const LAS unsigned char* Qw, const TileRegs& t, const Geo& g, int sbase,
                                             LAS unsigned char* Vw, LAS float* wsf, const LAS float* bt, const LAS float* neg, int lane) {
    const int r32 = lane & 31, hi = lane >> 5;
#pragma unroll
    for (int i = 0; i < 4; ++i) *(LAS v4u*)(Vw + i * 1024 + lane * 16) = t.v[i];
    f32x16 S = {0.f, 0.f, 0.f, 0.f, 0.f, 0.f, 0.f, 0.f, 0.f, 0.f, 0.f, 0.f, 0.f, 0.f, 0.f, 0.f};
#pragma unroll
    for (int ks = 0; ks < 4; ++ks) { const bf16x8 qf = *(const LAS bf16x8*)(Qw + ks * 1024 + lane * 16); S = __builtin_amdgcn_mfma_f32_32x32x16_bf16(t.k[ks], qf, S, 0, 0, 0); }
    {
        const int sq = sbase + (r32 & g.im);
        const int qh = (r32 >> 4) & g.hb;
        const LAS float* bl = bt + (sq + 64 - 15 - 4 * hi);
        const LAS float* b0 = (g.hb && qh != 0) ? neg : bl;
        const LAS float* b1 = (g.hb && qh != 1) ? neg : bl - (g.hb ? 0 : 16);
#pragma unroll
        for (int r = 0; r < 16; ++r) { const int e0 = (r & 3) + 8 * ((r >> 2) & 1);
            S[r] += (r < 8 ? b0 : b1)[15 - e0]; }
    }
    float mx = S[0];
#pragma unroll
    for (int r = 1; r < 16; ++r) mx = fmaxf(mx, S[r]);
    mx = fmaxf(mx, __shfl_xor(mx, 32));
    if (__any(mx > st.m + THR)) {
        const float mn = fmaxf(st.m, mx);
        const float al = ex2(st.m - mn);
        st.l *= al; st.m = mn;
        if (hi == 0) wsf[r32] = al;
        LDS_WAIT();
#pragma unroll
        for (int r = 0; r < 16; ++r) { const float f = wsf[crow(r, hi)]; st.o0[r] *= f; st.o1[r] *= f; }
    }
    float ps = 0.f;
#pragma unroll
    for (int r = 0; r < 16; ++r) { S[r] = ex2(S[r] - st.m); ps += S[r]; }
    st.l += ps;
    const int g16 = lane >> 4, i16 = lane & 15, q4 = i16 >> 2, p4 = i16 & 3;
    const LAS unsigned char* vb = Vw + (4 * hi + q4) * 128 + (((2 * (g16 & 1)) + (p4 >> 1)) << 4) + 8 * (p4 & 1);
    const int xo = (q4 >> 1) * 64;
#pragma unroll
    for (int ks = 0; ks < 2; ++ks) {
        v4u pw; pw.x = cvtpk(S[8 * ks + 0], S[8 * ks + 1]); pw.y = cvtpk(S[8 * ks + 2], S[8 * ks + 3]); pw.z = cvtpk(S[8 * ks + 4], S[8 * ks + 5]); pw.w = cvtpk(S[8 * ks + 6], S[8 * ks + 7]);
        const bf16x8 pa = __builtin_bit_cast(bf16x8, pw);
        const s16x4 a0 = vtr(vb + ks * 2048 + (0 ^ xo)), a1 = vtr(vb + ks * 2048 + 1024 + (0 ^ xo));
        const s16x4 b0 = vtr(vb + ks * 2048 + (64 ^ xo)), b1 = vtr(vb + ks * 2048 + 1024 + (64 ^ xo));
        const bf16x8 v0 = (bf16x8){a0[0], a0[1], a0[2], a0[3], a1[0], a1[1], a1[2], a1[3]};
        const bf16x8 v1 = (bf16x8){b0[0], b0[1], b0[2], b0[3], b1[0], b1[1], b1[2], b1[3]};
        st.o0 = __builtin_amdgcn_mfma_f32_32x32x16_bf16(pa, v0, st.o0, 0, 0, 0);
        st.o1 = __builtin_amdgcn_mfma_f32_32x32x16_bf16(pa, v1, st.o1, 0, 0, 0);
    }
}

__device__ __forceinline__ void merge(LAS unsigned char* base, const WaveState& st, int tl, bool first, bool keep_l, int w, int lane) {
    const int r32 = lane & 31, hi = lane >> 5;
    LAS float* wsf = (LAS float*)(base + A_WS) + w * 128;
    LAS float* accL = (LAS float*)(base + A_ACCL);
    LAS unsigned short* accO = (LAS unsigned short*)(base + A_ACCO);
    const float lt = st.l + __shfl_xor(st.l, 32);
    const float lse = st.m + lg2(lt);
    const float rl = rcpf_(lt);
    float wA = 0.f, wB = rl, lnew = lse;
    if (!first) { const float la = accL[tl]; const float M = fmaxf(la, lse); const float ea = ex2(la - M), eb = ex2(lse - M); const float sm = ea + eb; lnew = M + lg2(sm); const float inv = rcpf_(sm); wA = ea * inv; wB = eb * inv * rl; }
    if (hi == 0) { wsf[r32] = wA; wsf[32 + r32] = wB; ((LAS int*)wsf)[64 + r32] = tl; if (keep_l) accL[tl] = lnew; }
    LDS_WAIT();
#pragma unroll
    for (int r = 0; r < 16; ++r) {
        const int q = crow(r, hi);
        const float a = wsf[q], b = wsf[32 + q]; const int tq = ((LAS int*)wsf)[64 + q];
        LAS unsigned short* p0 = accO + tq * 64 + r32;
        float n0 = b * st.o0[r], n1 = b * st.o1[r];
        if (!first) { n0 += a * bf1(p0[0]); n1 += a * bf1(p0[32]); }
        p0[0] = (unsigned short)f2bf(n0); p0[32] = (unsigned short)f2bf(n1);
    }
}

__device__ __forceinline__ void attn_unit(Frame& F, const Args& A, int b, int h, int J, BgCopy& bg) {
    LAS unsigned char* base = F.lds + RING_OFF;
    const int lane = F.lane, w = F.wave, r32 = lane & 31, hi = lane >> 5;
    const bf16* P = (const bf16*)(F.ws + WS_P);
    const size_t rowb = (size_t)b * SEQ;
    const bf16* Qh = P + 0 * PREG + rowb * 1024 + h * 64;
    const bf16* Kh = P + 1 * PREG + rowb * 1024 + h * 64;
    const bf16* Vh = P + 2 * PREG + rowb * 1024 + h * 64;
    { const float* TAB = (const float*)(F.ws + WS_TAB) + TAB_BT + h * 396; LAS float* bt = (LAS float*)(base + A_BT);
      for (int i = F.tid; i < 3 * 256 + 64; i += NWAVES * 64) { const int p = i >> 8, u = i & 255, sd = u - 64; bt[i] = (i < 768 && sd >= 0 && sd <= 128) ? TAB[p * 132 + sd] : -INFINITY; } }
    __syncthreads();
    const LAS float* neg = (const LAS float*)(base + A_NEG);
    LAS unsigned char* Vw0 = base + A_KV + w * 8192;
    LAS unsigned char* Qw = Vw0 + 4096;
    const float* cck = A.in[2]; const float* ccv = A.in[3];
    LAS float* wsf = (LAS float*)(base + A_WS) + w * 128;
#pragma unroll 1
    for (int pat = 0; pat < 3; ++pat) {
        Geo g; int qp0, tl;
        if (pat == 0)      { g.dil = 16; g.im = 15; g.hb = 1; g.res = 2 * w;  qp0 = 16 * J;                 tl = 16 * (r32 & 15) + 2 * w + (r32 >> 4); }
        else if (pat == 1) { g.dil = 4;  g.im = 31; g.hb = 0; g.res = w & 3;  qp0 = 64 * J + 32 * (w >> 2); tl = 4 * (32 * (w >> 2) + r32) + (w & 3); }
        else               { g.dil = 1;  g.im = 31; g.hb = 0; g.res = 0;      qp0 = 256 * J + 32 * w;       tl = 32 * w + r32; }
        const LAS float* bt = (const LAS float*)(base + A_BT) + (2 - pat) * 256;
        { const bf16* qrow = Qh + (size_t)tok_of(g, qp0, r32) * 1024 + 8 * hi;
#pragma unroll
          for (int ks = 0; ks < 4; ++ks) { const bf16x8 qv = *(const bf16x8*)(qrow + 16 * ks); *(LAS bf16x8*)(Qw + ks * 1024 + lane * 16) = qv; } }
        WaveState st; st.m = -INFINITY; st.l = 0.f;
#pragma unroll
        for (int r = 0; r < 16; ++r) { st.o0[r] = 0.f; st.o1[r] = 0.f; }
        int kp, kend, kstep, sb;
        if (pat == 0) { kp = 0; kend = 16 * J; kstep = 16; sb = 16 * J; }
        else { kp = qp0 - 128; kend = qp0; kstep = 32; sb = 128; if (kp < 0) { sb += kp; kp = 0; } }
        TileRegs ta, tb; TilePtrs tp;
        tile_ptrs(tp, Kh, Vh, g, lane);
        const long tstr = (long)g.dil * 2048;
        tile_issue(ta, tp, (long)kp * tstr);
#pragma unroll 1
        for (;;) {
            bool more = (kp + kstep <= kend);
            tile_issue(tb, tp, (long)(more ? kp + kstep : kp) * tstr);
#if BG_ON
            bg_step<0>(bg, cck, ccv, F.out, lane);
#endif
            tile_compute(st, Qw, ta, g, sb, Vw0, wsf, bt, neg, lane);
            if (!more) break;
            kp += kstep; sb -= kstep;
            more = (kp + kstep <= kend);
            tile_issue(ta, tp, (long)(more ? kp + kstep : kp) * tstr);
#if BG_ON
            bg_step<1>(bg, cck, ccv, F.out, lane);
#endif
            tile_compute(st, Qw, tb, g, sb, Vw0, wsf, bt, neg, lane);
            if (!more) break;
            kp += kstep; sb -= kstep;
        }
        merge(base, st, tl, pat == 0, pat < 2, w, lane);
        if (pat < 2) __syncthreads();
    }
    LDS_WAIT(); asm volatile("" ::: "memory");
    const int c8 = lane & 7;
    const LAS unsigned char* accO = base + A_ACCO;
    const bf16* GA = P + 3 * PREG; bf16* Y = (bf16*)(F.ws + WS_Y); float* SSQ = (float*)(F.ws + WS_SSQ);
    const float* nw = A.in[9] + h * 64 + 8 * c8;
    const f32x4 nw0 = *(const f32x4*)nw, nw1 = *(const f32x4*)(nw + 4);
#pragma unroll
    for (int i = 0; i < 4; ++i) {
        const int tloc = 32 * w + 8 * i + (lane >> 3);
        const size_t m = rowb + 256 * J + tloc;
        const v4u ov = *(const LAS v4u*)(accO + tloc * 128 + c8 * 16);
        const v4u gv = *(const v4u*)(GA + m * 1024 + h * 64 + 8 * c8);
        float o[8] = {bflo(ov.x), bfhi(ov.x), bflo(ov.y), bfhi(ov.y), bflo(ov.z), bfhi(ov.z), bflo(ov.w), bfhi(ov.w)};
        float gg[8] = {bflo(gv.x), bfhi(gv.x), bflo(gv.y), bfhi(gv.y), bflo(gv.z), bfhi(gv.z), bflo(gv.w), bfhi(gv.w)};
        float ss = 0.f;
#pragma unroll
        for (int k = 0; k < 8; ++k) ss += o[k] * o[k];
        ss += __shfl_xor(ss, 1); ss += __shfl_xor(ss, 2); ss += __shfl_xor(ss, 4);
        if (c8 == 0) SSQ[m * 32 + h] = ss;
        float y[8];
#pragma unroll
        for (int k = 0; k < 8; ++k) y[k] = o[k] * siluf_(gg[k]) * (k < 4 ? nw0[k] : nw1[k - 4]);
        v4u yo; yo.x = pk2(y[0], y[1]); yo.y = pk2(y[2], y[3]); yo.z = pk2(y[4], y[5]); yo.w = pk2(y[6], y[7]);
        *(v4u*)(Y + m * 2048 + h * 64 + 8 * c8) = yo;
    }
    __syncthreads();
}
}


namespace lru {
constexpr int TC = 64;
constexpr int L_XCS = 0;
constexpr int L_AB = 16384;
constexpr int L_HS = 81920;
constexpr int L_CW = 114688;
typedef float f32x2_t __attribute__((ext_vector_type(2)));
__device__ __forceinline__ void unpack8(const v4u a, float (&x)[8]) { x[0] = bflo(a.x); x[1] = bfhi(a.x); x[2] = bflo(a.y); x[3] = bfhi(a.y); x[4] = bflo(a.z); x[5] = bfhi(a.z); x[6] = bflo(a.w); x[7] = bfhi(a.w); }

__device__ __forceinline__ void lru_unit(Frame& F, const Args& A, int cb, int R0, int nrows, int TSEG, bool smp, int bidx0) {
    LAS unsigned char* base = F.lds + RING_OFF;
    const int tid = F.tid, w = F.wave;
    const bf16* P = (const bf16*)(F.ws + WS_P);
    const bf16* XR = P + 4 * PREG + cb * 64; const bf16* GR = P + 5 * PREG + cb * 64;
    bf16* Y = (bf16*)(F.ws + WS_Y) + 1024 + cb * 64; float* SSQ = (float*)(F.ws + WS_SSQ);
    const float* TAB = (const float*)(F.ws + WS_TAB);
    const int ch0 = cb * 64;
    const int nchunk = nrows / TC;
    { LAS float* cl = (LAS float*)(base + L_CW); if (tid < 384) { const int k = tid >> 6, c = tid & 63; cl[tid] = (k < 4) ? A.in[11][k * 1024 + ch0 + c] : (k == 4 ? A.in[12][ch0 + c] : A.in[10][ch0 + c]); } }
    __syncthreads();
#define LRU_BAR() do { asm volatile("s_waitcnt lgkmcnt(0)" ::: "memory"); __builtin_amdgcn_s_barrier(); asm volatile("" ::: "memory"); } while (0)
#define LRU_GLOAD(co, rbase) do { _Pragma("unroll") for (int k = 0; k < 4; ++k) gl[k] = *(const v4u*)(GR + ((size_t)R0 + (co) * TC + (rbase) + (lane >> 3) + 8 * k) * 1024 + c8); } while (0)
#define LRU_OUT(co, rbase) do { const LAS float* hs = (const LAS float*)(base + L_HS + ((co) & 1) * 16384); \
        _Pragma("unroll") for (int k = 0; k < 4; ++k) { const int row = (rbase) + (lane >> 3) + 8 * k; const size_t m = (size_t)R0 + (co) * TC + row; \
            const f32x4 h0 = *(const LAS f32x4*)(hs + row * 64 + c8), h1 = *(const LAS f32x4*)(hs + row * 64 + c8 + 4); \
            float g[8]; unpack8(gl[k], g); const float hv[8] = {h0[0], h0[1], h0[2], h0[3], h1[0], h1[1], h1[2], h1[3]}; float y[8], ss = 0.f; \
            _Pragma("unroll") for (int j = 0; j < 8; ++j) { ss += hv[j] * hv[j]; y[j] = hv[j] * siluf_(g[j]) * cwl[320 + j]; } \
            ss += __shfl_xor(ss, 1); ss += __shfl_xor(ss, 2); ss += __shfl_xor(ss, 4); \
            if ((lane & 7) == 0) SSQ[m * 32 + 16 + cb] = ss; \
            v4u y0; y0.x = pk2(y[0], y[1]); y0.y = pk2(y[2], y[3]); y0.z = pk2(y[4], y[5]); y0.w = pk2(y[6], y[7]); \
            *(v4u*)(Y + m * 2048 + c8) = y0; } } while (0)
    if (w == 0) {
      int ln = F.lane; asm volatile("" : "+v"(ln));
      const int lane = ln, c8 = 8 * (lane & 7);
      const LAS float* cwl = (const LAS float*)(base + L_CW) + c8;
      v4u gl[4];
      LRU_GLOAD(0, 32);
      float hcar = 0.f;
      for (int i = -2; i <= nchunk; ++i) {
        if (i >= 0 && i < nchunk) {
            const LAS f32x2_t* ab = (const LAS f32x2_t*)(base + L_AB + (i & 1) * 32768);
            LAS float* hs = (LAS float*)(base + L_HS + (i & 1) * 16384);
            if (!smp) {
#pragma unroll 16
                for (int r = 0; r < TC; ++r) { const f32x2_t v = ab[r * 64 + lane]; hcar = v.x * hcar + v.y; hs[r * 64 + lane] = hcar; }
                if (i == nchunk - 1) F.out[O_LP + (size_t)bidx0 * 1024 + ch0 + lane] = hcar;
            } else {
                float hin[8];
#pragma unroll
                for (int sg = 0; sg < 8; ++sg) hin[sg] = A.in[5][(size_t)(i * 8 + sg) * 1024 + ch0 + lane];
#pragma unroll
                for (int sg = 0; sg < 8; ++sg) {
                    hcar = hin[sg];
#pragma unroll
                    for (int r8 = 0; r8 < 8; ++r8) { const int r = sg * 8 + r8; const f32x2_t v = ab[r * 64 + lane]; hcar = v.x * hcar + v.y; hs[r * 64 + lane] = hcar; }
                    F.out[O_LS + (size_t)(i * 8 + sg) * 1024 + ch0 + lane] = hcar;
                }
            }
        }
        const int co = i - 1;
        if (co >= 0 && co < nchunk) { LRU_OUT(co, 32); if (co + 1 < nchunk) LRU_GLOAD(co + 1, 32); }
        LRU_BAR();
      }
    } else if (w <= 4) {
      int ln = F.lane; asm volatile("" : "+v"(ln));
      const int lane = ln;
      bf16x8 wb[2][4][2]; float bgx[4], bga[4], la0[4];
      { const bf16* WG = (const bf16*)(F.ws + WS_WG) + (size_t)cb * 2 * 4096;
#pragma unroll
        for (int g = 0; g < 2; ++g)
#pragma unroll
            for (int n = 0; n < 4; ++n)
#pragma unroll
                for (int ks = 0; ks < 2; ++ks) wb[g][n][ks] = *(const bf16x8*)(WG + g * 4096 + (16 * n + (lane & 15)) * 64 + 32 * ks + 8 * (lane >> 4));
#pragma unroll
        for (int n = 0; n < 4; ++n) { const int cg = ch0 + 16 * n + (lane & 15); bgx[n] = A.in[14][cg]; bga[n] = A.in[16][cg]; la0[n] = TAB[TAB_LA0 + cg] * LOG2E; } }
      for (int i = -2; i <= nchunk; ++i) {
        const int c = i + 1;
        if (c >= 0 && c < nchunk) {
            const LAS unsigned char* xs = base + L_XCS + (c & 1) * 8192;
            LAS f32x2_t* ab = (LAS f32x2_t*)(base + L_AB + (c & 1) * 32768);
            const int arow = 16 * (w - 1) + (lane & 15), g4 = lane >> 4, sw = (arow >> 1) & 7;
            bf16x8 af[2];
#pragma unroll
            for (int ks = 0; ks < 2; ++ks) af[ks] = *(const LAS bf16x8*)(xs + arow * 128 + (((4 * ks + g4) ^ sw) << 4));
#pragma unroll
            for (int n = 0; n < 4; ++n) {
                f32x4 ax = {0.f, 0.f, 0.f, 0.f}, aa = {0.f, 0.f, 0.f, 0.f};
#pragma unroll
                for (int ks = 0; ks < 2; ++ks) { ax = __builtin_amdgcn_mfma_f32_16x16x32_bf16(af[ks], wb[0][n][ks], ax, 0, 0, 0); aa = __builtin_amdgcn_mfma_f32_16x16x32_bf16(af[ks], wb[1][n][ks], aa, 0, 0, 0); }
                const int cl = 16 * n + (lane & 15);
#pragma unroll
                for (int rg = 0; rg < 4; ++rg) {
                    const int row = 16 * (w - 1) + 4 * g4 + rg;
                    const float xc = bf1(*(const LAS unsigned short*)(xs + row * 128 + ((((cl >> 3) ^ ((row >> 1) & 7))) << 4) + (cl & 7) * 2));
                    const float gx = sigmoidf_(ax[rg] + bgx[n]), ga = sigmoidf_(aa[rg] + bga[n]);
                    const float a = ex2(ga * la0[n]);
                    const float mult = __builtin_amdgcn_sqrtf(fmaxf(1.f - a * a, 0.f));
                    ab[row * 64 + cl] = (f32x2_t){a, mult * gx * xc};
                }
            }
        }
        LRU_BAR();
      }
    } else if (w <= 6) {
      int t6 = tid - 320; asm volatile("" : "+v"(t6));
      const int q4 = t6 >> 3, c8 = 8 * (t6 & 7);
      const LAS float* cwl = (const LAS float*)(base + L_CW) + c8;
      v4u xl[7];
#define LRU_XLOAD(cc) do { _Pragma("unroll") for (int k = 0; k < 7; ++k) { int rs = (cc) * TC + 4 * q4 - 3 + k; rs = rs < 0 ? 0 : rs; xl[k] = *(const v4u*)(XR + ((size_t)R0 + rs) * 1024 + c8); } } while (0)
      LRU_XLOAD(0);
      for (int i = -2; i <= nchunk; ++i) {
        const int cc = i + 2;
        if (cc < nchunk) {
            LAS unsigned char* xs = base + L_XCS + (cc & 1) * 8192;
            const int rr0 = cc * TC + 4 * q4;
            float xv[7][8];
#pragma unroll
            for (int k = 0; k < 7; ++k) unpack8(xl[k], xv[k]);
            if (cc + 1 < nchunk) LRU_XLOAD(cc + 1);
            if (!smp) { if (rr0 == 0) {
#pragma unroll
                    for (int k = 0; k < 3; ++k)
#pragma unroll
                        for (int j = 0; j < 8; ++j) xv[k][j] = 0.f; } }
            else if ((rr0 & 4) == 0) {
                const float* cp = A.in[4] + (size_t)(rr0 >> 3) * 3 * 1024 + ch0 + c8;
#pragma unroll
                for (int k = 0; k < 3; ++k) { const f32x4 c0 = *(const f32x4*)(cp + k * 1024), c1 = *(const f32x4*)(cp + k * 1024 + 4);
                    xv[k][0] = c0[0]; xv[k][1] = c0[1]; xv[k][2] = c0[2]; xv[k][3] = c0[3]; xv[k][4] = c1[0]; xv[k][5] = c1[1]; xv[k][6] = c1[2]; xv[k][7] = c1[3]; }
            }
#pragma unroll
            for (int r = 0; r < 4; ++r) {
                const int row = 4 * q4 + r, rr = rr0 + r;
                float xc[8];
#pragma unroll
                for (int j = 0; j < 8; ++j) xc[j] = cwl[256 + j] + cwl[j] * xv[r][j] + cwl[64 + j] * xv[r + 1][j] + cwl[128 + j] * xv[r + 2][j] + cwl[192 + j] * xv[r + 3][j];
                const int tin = smp ? (rr & 7) : rr;
                if (tin >= TSEG - 3) { float* co = F.out + (smp ? O_CS : O_CP) + ((size_t)(smp ? (rr >> 3) : bidx0) * 3 + (tin - (TSEG - 3))) * 1024 + ch0 + c8;
                    *(f32x4*)(co) = (f32x4){xv[r + 3][0], xv[r + 3][1], xv[r + 3][2], xv[r + 3][3]}; *(f32x4*)(co + 4) = (f32x4){xv[r + 3][4], xv[r + 3][5], xv[r + 3][6], xv[r + 3][7]}; }
                v4u s0; s0.x = pk2(xc[0], xc[1]); s0.y = pk2(xc[2], xc[3]); s0.z = pk2(xc[4], xc[5]); s0.w = pk2(xc[6], xc[7]);
                *(LAS v4u*)(xs + row * 128 + ((((t6 & 7)) ^ ((row >> 1) & 7)) << 4)) = s0;
            }
        }
        LRU_BAR();
      }
#undef LRU_XLOAD
    } else {
      int ln = F.lane; asm volatile("" : "+v"(ln));
      const int lane = ln, c8 = 8 * (lane & 7);
      const LAS float* cwl = (const LAS float*)(base + L_CW) + c8;
      v4u gl[4];
      LRU_GLOAD(0, 0);
      for (int i = -2; i <= nchunk; ++i) {
        const int co = i - 1;
        if (co >= 0 && co < nchunk) { LRU_OUT(co, 0); if (co + 1 < nchunk) LRU_GLOAD(co + 1, 0); }
        LRU_BAR();
      }
    }
#undef LRU_GLOAD
#undef LRU_OUT
#undef LRU_BAR
}
}

__device__ __forceinline__ void copy_phase(Frame& F, const Args& A, att::BgCopy& bg) {
    const float* ck = A.in[2]; const float* cv = A.in[3];
    const int lane = F.lane;
    att::bg_flush(bg, F.out, lane);
    unsigned i0 = bg.cur;
    for (; i0 + 512u <= bg.end; i0 += 512u) {
        f32x4 v[8];
#pragma unroll
        for (int u = 0; u < 8; ++u) v[u] = __builtin_nontemporal_load(att::bg_src(ck, cv, i0 + (unsigned)lane + 64u * u));
#pragma unroll
        for (int u = 0; u < 8; ++u) __builtin_nontemporal_store(v[u], att::bg_dst(F.out, i0 + (unsigned)lane + 64u * u));
    }
    for (unsigned ix = i0 + (unsigned)lane; ix < bg.end; ix += 64u) { const f32x4 v = __builtin_nontemporal_load(att::bg_src(ck, cv, ix)); __builtin_nontemporal_store(v, att::bg_dst(F.out, ix)); }
    bg.cur = bg.end;
}

namespace smp {
#ifndef SMP_STAMP
#define SMP_STAMP(k) do {} while (0)
#endif
__device__ __forceinline__ void unit(Frame& F, const Args& A, int b, int g) {
    int ln_ = F.lane; asm volatile("" : "+v"(ln_));
    const int t = F.wave, lane = ln_;
    const int m = MP + b * 8 + t;
    const bf16* P = (const bf16*)(F.ws + WS_P);
    const float* TAB = (const float*)(F.ws + WS_TAB) + TAB_BT;
    float* SPO = (float*)(F.ws + WS_SPO); float* SPM = (float*)(F.ws + WS_SPM); float* SPL = SPM + 32 * 8 * 8 * 16;
    float q[4][4];
#pragma unroll
    for (int i = 0; i < 4; ++i) { const v2u qv = *(const v2u*)(P + (size_t)m * 1024 + 256 * i + 4 * lane); q[i][0] = bflo(qv.x); q[i][1] = bfhi(qv.x); q[i][2] = bflo(qv.y); q[i][3] = bfhi(qv.y); }
    float mr[4], l[4], o[4][4];
#pragma unroll
    for (int i = 0; i < 4; ++i) { mr[i] = -INFINITY; l[i] = 0.f; o[i][0] = o[i][1] = o[i][2] = o[i][3] = 0.f; }
    const float* ck = A.in[2] + (size_t)b * 2048 * 1024; const float* cv = A.in[3] + (size_t)b * 2048 * 1024;
    float* nk = F.out + O_KS + (size_t)b * 2048 * 1024; float* nv = F.out + O_VS + (size_t)b * 2048 * 1024;
#define SMP_VISIT(v_) int j_, p_, s_, mult_; bool copy_; { const int vv = (v_); \
        if (vv < 12) { const int k = 12 * g + vv; j_ = 16 * k + t; p_ = 2; s_ = 128 - k; mult_ = 1; copy_ = (j_ >= 8); } \
        else if (vv < 24) { const int i2 = 12 * g + vv - 12; j_ = 1536 + t + 4 * i2; p_ = 1; s_ = 128 - i2; mult_ = ((i2 & 3) == 0) ? 2 : 1; copy_ = ((i2 & 1) == 0); } \
        else { int n = 17 * g + vv - 24; const bool ok = (n <= 128); n = ok ? n : 128; j_ = 1920 + t + n; p_ = 0; s_ = 128 - n; mult_ = ok ? (1 + ((s_ & 3) == 0 ? 1 : 0) + ((s_ & 15) == 0 ? 1 : 0)) : 0; copy_ = ok && ((n & 7) == 0) && (j_ < 2048); } }
#define SMP_LOAD(K4, V4, v_) do { SMP_VISIT(v_) (void)p_; (void)s_; (void)mult_; (void)copy_; \
        const float* kr = (j_ < 2048) ? ck + (size_t)j_ * 1024 : nk + (size_t)(j_ - 8) * 1024; const float* vr = (j_ < 2048) ? cv + (size_t)j_ * 1024 : nv + (size_t)(j_ - 8) * 1024; \
        _Pragma("unroll") for (int i = 0; i < 4; ++i) { K4[i] = *(const f32x4*)(kr + 256 * i + 4 * lane); V4[i] = *(const f32x4*)(vr + 256 * i + 4 * lane); } } while (0)
#define SMP_PROC(K4, V4, v_) do { SMP_VISIT(v_) \
        if (copy_) { f32x4* ko = (f32x4*)(nk + (size_t)(j_ - 8) * 1024) + lane; f32x4* vo = (f32x4*)(nv + (size_t)(j_ - 8) * 1024) + lane; \
          _Pragma("unroll") for (int i = 0; i < 4; ++i) { __builtin_nontemporal_store(K4[i], ko + 64 * i); __builtin_nontemporal_store(V4[i], vo + 64 * i); } } \
        if (mult_ > 0) { const float fm = (float)mult_; \
        _Pragma("unroll") for (int i = 0; i < 4; ++i) { \
            float d = K4[i][0] * q[i][0] + K4[i][1] * q[i][1] + K4[i][2] * q[i][2] + K4[i][3] * q[i][3]; \
            d += __shfl_xor(d, 1); d += __shfl_xor(d, 2); d += __shfl_xor(d, 4); d += __shfl_xor(d, 8); \
            const int hd = 4 * i + (lane >> 4); \
            const float s2 = d + TAB[hd * 396 + p_ * 132 + s_]; \
            const float mn = fmaxf(mr[i], s2), al = ex2(mr[i] - mn), pp = fm * ex2(s2 - mn); \
            l[i] = l[i] * al + pp; mr[i] = mn; \
            _Pragma("unroll") for (int k = 0; k < 4; ++k) o[i][k] = o[i][k] * al + pp * V4[i][k]; } } } while (0)
    {
        f32x4 k0[4], v0[4], k1[4], v1[4], k2[4], v2[4];
#define SMP_RANGE(va, vb) do { const int ve_ = (vb); \
        SMP_LOAD(k0, v0, (va)); SMP_LOAD(k1, v1, ((va) + 1 < ve_) ? (va) + 1 : ve_ - 1); \
        _Pragma("unroll 1") for (int v = (va); v < ve_; v += 3) { \
            SMP_LOAD(k2, v2, (v + 2 < ve_) ? v + 2 : ve_ - 1); SMP_PROC(k0, v0, v); \
            SMP_LOAD(k0, v0, (v + 3 < ve_) ? v + 3 : ve_ - 1); if (v + 1 < ve_) SMP_PROC(k1, v1, v + 1); \
            SMP_LOAD(k1, v1, (v + 4 < ve_) ? v + 4 : ve_ - 1); if (v + 2 < ve_) SMP_PROC(k2, v2, v + 2); } } while (0)
        SMP_STAMP(0);
        SMP_RANGE(0, 12);
        SMP_STAMP(1);
        SMP_RANGE(12, 24);
        SMP_STAMP(2);
        SMP_RANGE(24, 41);
        SMP_STAMP(3);
#undef SMP_RANGE
    }
#undef SMP_VISIT
#undef SMP_LOAD
#undef SMP_PROC
    const size_t pi = ((size_t)(b * 8 + g) * 8 + t);
#pragma unroll
    for (int i = 0; i < 4; ++i) {
        *(f32x4*)(SPO + pi * 1024 + 256 * i + 4 * lane) = (f32x4){o[i][0], o[i][1], o[i][2], o[i][3]};
        if ((lane & 15) == 0) { const int hd = 4 * i + (lane >> 4); SPM[pi * 16 + hd] = mr[i]; SPL[pi * 16 + hd] = l[i]; }
    }
    VM_WAIT(); __syncthreads();
    if (F.tid == 0) {
        __builtin_amdgcn_fence(__ATOMIC_RELEASE, "agent");
        asm volatile("s_waitcnt vmcnt(0)" ::: "memory");
        const unsigned old = __hip_atomic_fetch_add((unsigned*)(F.ctl + CW_SCNT + 64 * b), 1u, __ATOMIC_RELAXED, __HIP_MEMORY_SCOPE_AGENT);
        const unsigned last = (old == 7u) ? 1u : 0u;
        if (last) { __builtin_amdgcn_fence(__ATOMIC_ACQUIRE, "agent"); asm volatile("s_waitcnt vmcnt(0)" ::: "memory"); }
        F.MISC[16] = last;
    }
    __syncthreads();
    const bool last = F.MISC[16] != 0u;
    __syncthreads();
    if (!last) return;
    float M[4], L[4], O[4][4];
#pragma unroll
    for (int i = 0; i < 4; ++i) { M[i] = -INFINITY; L[i] = 0.f; O[i][0] = O[i][1] = O[i][2] = O[i][3] = 0.f; }
    for (int gg = 0; gg < 8; ++gg) { const size_t pj = ((size_t)(b * 8 + gg) * 8 + t);
#pragma unroll
        for (int i = 0; i < 4; ++i) M[i] = fmaxf(M[i], SPM[pj * 16 + 4 * i + (lane >> 4)]); }
    for (int gg = 0; gg < 8; ++gg) { const size_t pj = ((size_t)(b * 8 + gg) * 8 + t);
#pragma unroll
        for (int i = 0; i < 4; ++i) { const int hd = 4 * i + (lane >> 4); const float wgt = ex2(SPM[pj * 16 + hd] - M[i]); L[i] += SPL[pj * 16 + hd] * wgt;
            const f32x4 ov = *(const f32x4*)(SPO + pj * 1024 + 256 * i + 4 * lane);
#pragma unroll
            for (int k = 0; k < 4; ++k) O[i][k] += ov[k] * wgt; } }
    bf16* Y = (bf16*)(F.ws + WS_Y); float* SSQ = (float*)(F.ws + WS_SSQ);
#pragma unroll
    for (int i = 0; i < 4; ++i) {
        const float rl = 1.f / L[i]; float ov[4], ss = 0.f;
#pragma unroll
        for (int k = 0; k < 4; ++k) { ov[k] = O[i][k] * rl; ss += ov[k] * ov[k]; }
        ss += __shfl_xor(ss, 1); ss += __shfl_xor(ss, 2); ss += __shfl_xor(ss, 4); ss += __shfl_xor(ss, 8);
        const int col = 256 * i + 4 * lane;
        if ((lane & 15) == 0) SSQ[(size_t)m * 32 + 4 * i + (lane >> 4)] = ss;
        const v2u gv = *(const v2u*)(P + 3 * PREG + (size_t)m * 1024 + col);
        const f32x4 nw = *(const f32x4*)(A.in[9] + col);
        const float g0 = bflo(gv.x), g1 = bfhi(gv.x), g2 = bflo(gv.y), g3 = bfhi(gv.y);
        v2u yo; yo.x = pk2(ov[0] * siluf_(g0) * nw[0], ov[1] * siluf_(g1) * nw[1]); yo.y = pk2(ov[2] * siluf_(g2) * nw[2], ov[3] * siluf_(g3) * nw[3]);
        *(v2u*)(Y + (size_t)m * 2048 + col) = yo;
    }
}
}


__device__ __forceinline__ void final_norm(Frame& F, const Args& A) {
    const int gw = F.vcu * NWAVES + F.wave, NGW = F.G * NWAVES;
    const GAS f32x4* gf = (const GAS f32x4*)A.in[19] + F.lane;
    for (int m = gw; m < MT; m += NGW) {
        GAS f32x4* zr = (GAS f32x4*)(F.out + (size_t)m * DM) + F.lane;
        f32x4 v[4]; float s = 0.f;
#pragma unroll
        for (int j = 0; j < 4; ++j) { v[j] = zr[64 * j]; s += (v[j].x * v[j].x + v[j].y * v[j].y) + (v[j].z * v[j].z + v[j].w * v[j].w); }
        const float rstd = 1.f / sqrtf(wave_sum(s) * (1.f / DM) + EPS);
#pragma unroll
        for (int j = 0; j < 4; ++j) { const f32x4 g = gf[64 * j]; zr[64 * j] = (f32x4){v[j].x * rstd * g.x, v[j].y * rstd * g.y, v[j].z * rstd * g.z, v[j].w * rstd * g.w}; }
    }
}

__device__ __forceinline__ void sample_outproj(Frame& F, const Args& A) {
    int ln_ = F.lane; asm volatile("" : "+v"(ln_));
    const int lane = ln_, r16 = lane & 15, g4 = lane >> 4, w = F.wave, half = w >> 2;
    const bf16* Y = (const bf16*)(F.ws + WS_Y) + (size_t)MP * 2048; const bf16* W = (const bf16*)(F.ws + WS_WOUT);
    const float* SSQ = (const float*)(F.ws + WS_SSQ) + (size_t)MP * 32;
    LAS float* xch = (LAS float*)(F.lds + RING_OFF) + (w & 3) * 256;
    for (int t0 = F.vcu * 4; t0 < 1024; t0 += F.G * 4) {
        const int t = t0 + (w & 3), tr = t >> 6, tc = t & 63;
        const bf16* ap = Y + (size_t)(16 * tr + r16) * 2048 + 8 * g4 + 1024 * half;
        const bf16* bp = W + (size_t)(16 * tc + r16) * 2048 + 8 * g4 + 1024 * half;
        f32x4 acc = {0.f, 0.f, 0.f, 0.f};
#pragma unroll 1
        for (int k0 = 0; k0 < 32; k0 += 8) {
            bf16x8 af[8], bfm[8];
#pragma unroll
            for (int k = 0; k < 8; ++k) { af[k] = *(const bf16x8*)(ap + 32 * (k0 + k)); bfm[k] = *(const bf16x8*)(bp + 32 * (k0 + k)); }
#pragma unroll
            for (int k = 0; k < 8; ++k) acc = __builtin_amdgcn_mfma_f32_16x16x32_bf16(af[k], bfm[k], acc, 0, 0, 0);
        }
        float rsc;
        { const f32x4* sp = (const f32x4*)(SSQ + (size_t)(16 * tr + r16) * 32 + 16 * half); float sa = 0.f;
#pragma unroll
          for (int k = 0; k < 4; ++k) { const f32x4 a = sp[k]; sa += (a[0] + a[1]) + (a[2] + a[3]); }
          rsc = 1.f / sqrtf(sa * (1.f / 1024.f) + EPS); }
        float v[4];
#pragma unroll
        for (int r = 0; r < 4; ++r) v[r] = __shfl(rsc, 4 * g4 + r) * acc[r];
        if (half == 1) { *(LAS f32x4*)(xch + lane * 4) = (f32x4){v[0], v[1], v[2], v[3]}; }
        __syncthreads();
        if (half == 0) {
            const f32x4 o = *(const LAS f32x4*)(xch + lane * 4);
#pragma unroll
            for (int r = 0; r < 4; ++r) { const size_t idx = (size_t)(16 * tr + 4 * g4 + r) * 1024 + 16 * tc + r16; F.out[O_YS + idx] = A.in[1][idx] + v[r] + o[r]; }
        }
        __syncthreads();
    }
}

__device__ __forceinline__ void copy_range(Frame& F, att::BgCopy& bg) {
    const unsigned per = (att::N4 + (unsigned)F.G - 1u) / (unsigned)F.G, lo = (unsigned)F.vcu * per, hi = (lo + per < att::N4) ? lo + per : att::N4;
    const unsigned pw = (((hi - lo) + 7u) / 8u + 127u) & ~127u;
    unsigned c0 = lo + (unsigned)F.wave * pw, c1 = c0 + pw; if (c0 > hi) c0 = hi; if (c1 > hi) c1 = hi;
    bg.cur = c0; bg.end = c1; bg.pend0 = c1; bg.pend1 = c1; bg.dump = (f32x4*)(F.ws + 420 * MiB) + (size_t)blockIdx.x * 512 + F.tid;
    bg.a0 = bg.a1 = bg.b0 = bg.b1 = (f32x4){0.f, 0.f, 0.f, 0.f};
}

__global__ void __launch_bounds__(NWAVES * 64, 2) fwd_kernel(Args args) {
    extern __shared__ __attribute__((aligned(16))) unsigned char lds[];
    Frame F;
    F.lds = (LAS unsigned char*)lds;
    F.MISC = (volatile LAS unsigned*)(F.lds + MISC_OFF);
    F.tid = threadIdx.x; F.lane = F.tid & 63; F.wave = __builtin_amdgcn_readfirstlane(F.tid >> 6);
    F.G = gridDim.x; { const int bx = blockIdx.x; F.vcu = (F.G % 8 == 0) ? (bx % 8) * (F.G / 8) + bx / 8 : bx; }
    F.out = args.out; F.ws = args.ws;
    F.ctl = (gu32*)(args.ws + WS_CTL);
    for (int u = F.tid; u < (LDS_BYTES - LDSCTL_OFF) / 4; u += NWAVES * 64) ((LAS unsigned*)(F.lds + LDSCTL_OFF))[u] = 0u;
    __syncthreads();
    XcdBarrier bar; bar.bar = (unsigned*)(F.ctl + CW_BAR); bar.x = 0; bar.st = nullptr;
    if (N_LAUNCHES != PER_PHASE) bar = xcd_barrier_post((unsigned*)(F.ctl + CW_BAR), F.MISC + 8);
#define GRID_BAR() do { if (N_LAUNCHES != PER_PHASE) xcd_barrier(bar); } while (0)
    const int lo = args.ph_lo, hi = args.ph_hi;
#ifndef PHASE_MASK
#define PHASE_MASK 0xff
#endif
#define IN(k) (((PHASE_MASK >> (k)) & 1) && lo <= (k) && (k) < hi)
#define BOTH(k) (IN(k) && IN((k) + 1))

    if (IN(0)) { p0_prologue(F, args); if (BOTH(0)) GRID_BAR(); }

    if (IN(1)) {
        pg8::Gemm g{(const pg8::bf16_t*)(F.ws + WS_XN), (const pg8::bf16_t*)(F.ws + WS_WIN), MT, NPROJ, DM};
        pg8::StaticOrder S; S.init(MT, NPROJ, F.G, (int)blockIdx.x);
        pg8::EpiProj E{(pg8::bf16_t*)(F.ws + WS_P), F.out};
        pg8::gemm_phase<pg8::EpiProj, pg8::StaticOrder, PG8_ALIGN, PG8_SP2>(F.lds + RING_OFF, g, S, E);
        if (BOTH(1)) GRID_BAR();
    }

    if (IN(2)) {
#ifndef P2_MASK
#define P2_MASK 15
#endif
        if (P2_MASK & 1) for (int u = F.vcu; u < 144; u += F.G) {
            if (u < 128) lru::lru_unit(F, args, u & 15, (u >> 4) * SEQ, SEQ, SEQ, false, u >> 4);
            else lru::lru_unit(F, args, u - 128, MP, MS, DECT, true, 0);
        }
        {
            att::BgCopy bg; bg.cur = 0; bg.end = 0; bg.pend0 = 0; bg.pend1 = 0; bg.dump = nullptr;
            const unsigned myq = xb_xcc_id() & 7u;
            for (unsigned qi = 0; qi < 8u; ++qi) {
                const unsigned q = (myq + qi) & 7u;
                for (;;) {
                    if (F.tid == 0) F.MISC[17] = __hip_atomic_fetch_add((unsigned*)(F.ctl + CW_QA + 64 * q), 1u, __ATOMIC_RELAXED, __HIP_MEMORY_SCOPE_AGENT);
                    __syncthreads();
                    const unsigned idx = F.MISC[17];
                    __syncthreads();
                    if (idx >= 192u) break;
                    Frame Fu = F; { int tt = F.tid; asm volatile("" : "+v"(tt)); Fu.tid = tt; Fu.lane = tt & 63; }
                    const unsigned third = idx / 3u, rem = idx - 3u * third;
                    if (rem == 0u) {
                        if (third < 32u) { const unsigned u = q * 32u + third; if (P2_MASK & 4) smp::unit(Fu, args, (int)(u >> 3), (int)(u & 7u)); }
                        else { const unsigned c = q * 32u + (third - 32u);
                            if (P2_MASK & 8) { const unsigned per = att::N4 / 256u, pw = per / 8u; bg.cur = c * per + (unsigned)F.wave * pw; bg.end = bg.cur + pw; bg.pend0 = bg.pend1 = bg.end; copy_phase(Fu, args, bg); } }
                    } else if (P2_MASK & 2) {
                        const unsigned ai = idx - third - 1u;
                        const int J = 7 - (int)(ai >> 4), bh = (int)(q * 16u + (ai & 15u));
                        att::attn_unit(Fu, args, bh >> 4, bh & 15, J, bg);
                    }
                }
            }
        }
        if (BOTH(2)) GRID_BAR();
    }

    if (IN(3)) {
        pg8::Gemm g{(const pg8::bf16_t*)(F.ws + WS_Y), (const pg8::bf16_t*)(F.ws + WS_WOUT), MP, DM, DMIX};
        pg8::StaticOrder S; S.init(MP, DM, F.G, (int)blockIdx.x);
        LAS float* rs = (LAS float*)(F.lds + RS_OFF);
        {
            const float* SSQ = (const float*)(F.ws + WS_SSQ);
            pg8::Unit uu;
            for (int i = 0; i < 2; ++i) if (S.next(i, uu)) {
                if (F.tid < 256) { const float* sp = SSQ + ((size_t)uu.pm * 256 + F.tid) * 32; float sa = 0.f, sl = 0.f;
#pragma unroll
                    for (int k = 0; k < 16; ++k) { sa += sp[k]; sl += sp[16 + k]; }
                    const float ra = 1.f / sqrtf(sa * (1.f / 1024.f) + EPS), rl = 1.f / sqrtf(sl * (1.f / 1024.f) + EPS);
                    rs[i * 512 + F.tid * 2] = ra / rl; rs[i * 512 + F.tid * 2 + 1] = rl; }
            }
        }
        __syncthreads();
        pg8::EpiOut E{args.in[0], args.in[1], F.out, (const PG8_LAS float*)rs};
        pg8::gemm_phase<pg8::EpiOut, pg8::StaticOrder, PG8_ALIGN, PG8_SP2>(F.lds + RING_OFF, g, S, E);
        sample_outproj(F, args);
        if (BOTH(3)) GRID_BAR();
    }

    if (IN(4)) { final_norm(F, args); }
#undef IN
#undef BOTH
#undef GRID_BAR
}

extern "C" void kernel_launch(void* const* d_in, const int* in_sizes, int n_in, void* d_out, int out_size, void* d_ws, size_t ws_size, hipStream_t stream) {
    static int grid = 0;
    if (grid == 0) {
        if (n_in != 20 || ws_size < WS_END) { fprintf(stderr, "kernel_launch: unexpected n_in %d / ws %zu\n", n_in, ws_size); grid = -1; return; }
        int dev = 0, cus = 0, per_cu = 0;
        if (hipGetDevice(&dev) != hipSuccess || hipDeviceGetAttribute(&cus, hipDeviceAttributeMultiprocessorCount, dev) != hipSuccess) { grid = -1; return; }
        if (hipFuncSetAttribute((const void*)fwd_kernel, hipFuncAttributeMaxDynamicSharedMemorySize, LDS_BYTES) != hipSuccess) { fprintf(stderr, "kernel_launch: hipFuncSetAttribute failed\n"); grid = -1; return; }
        if (hipOccupancyMaxActiveBlocksPerMultiprocessor(&per_cu, (const void*)fwd_kernel, NWAVES * 64, LDS_BYTES) != hipSuccess || per_cu < 1)
            fprintf(stderr, "kernel_launch: note: occupancy query reports %d workgroups per CU\n", per_cu);
        (void)hipGetLastError();
        grid = cus;
    }
    if (grid < 0) return;
    if (N_LAUNCHES != PER_PHASE) { if (hipMemsetAsync((char*)d_ws + WS_CTL, 0, CTL_ZERO_BYTES, stream) != hipSuccess) return; }
    else { if (hipMemsetAsync((char*)d_ws + WS_CTL, 0, CTL_ZERO_BYTES, stream) != hipSuccess) return; }
    Args a{};
    for (int i = 0; i < 20; ++i) a.in[i] = (const float*)d_in[i];
    a.out = (float*)d_out; a.ws = (unsigned char*)d_ws;
    if (N_LAUNCHES == 1) {
        a.ph_lo = 0; a.ph_hi = PER_PHASE; a.li = 0;
        hipLaunchKernelGGL(fwd_kernel, dim3(grid), dim3(NWAVES * 64), LDS_BYTES, stream, a);
    } else {
        for (int li = 0; li < PER_PHASE; ++li) { a.ph_lo = li; a.ph_hi = li + 1; a.li = li;
            hipLaunchKernelGGL(fwd_kernel, dim3(grid), dim3(NWAVES * 64), LDS_BYTES, stream, a); }
    }
}
```
